# Optimizing an MI355X kernel written in HIP

```python
import jax, jax.numpy as jnp
from jax import lax
import numpy as np

D_MODEL = 1024
BATCH = 8
SEQ = 2048
DEPTH = 1
DEC_BATCH = 128
DEC_SEQ = 4
PAST_LEN = 16384
PAGE_SIZE = 128

PLE_DIM = 256
D_FF = 2816
EPS = 1e-6
SSD_HEADS = 16
SSD_HEADDIM = 64
SSD_DINNER = SSD_HEADS * SSD_HEADDIM
SSD_STATE = 128
SSD_GROUPS = 2
CONV_W = 4
SSD_CHUNK = 128
CONV_DIM = SSD_DINNER + 2 * SSD_GROUPS * SSD_STATE
HG_HEADS = 8
HG_DK = 128
HG_DV = 128
HG_WIDTH = HG_HEADS * HG_DV
HG_CHUNK = 16
D_MIX = SSD_DINNER + HG_WIDTH
D_IN_PROJ = SSD_DINNER + CONV_DIM + SSD_HEADS + 2 * HG_HEADS * HG_DK + 2 * HG_WIDTH

kernel_name = "hymba_ssd_hgrn2_macaron_step"


def _rmsnorm(x, w):
    xf = x.astype(jnp.float32)
    r = lax.rsqrt(jnp.mean(xf * xf, axis=-1, keepdims=True) + EPS)
    return (xf * r * w.astype(jnp.float32)).astype(x.dtype)


def _swiglu(h, w_up, w_down):
    g, u = jnp.split(h @ w_up, 2, axis=-1)
    return (jax.nn.silu(g) * u) @ w_down


def _pad_time(t, npad):
    if npad == 0:
        return t
    return jnp.pad(t, [(0, 0), (0, npad)] + [(0, 0)] * (t.ndim - 2))


def _ssd_chunked(x, dt, a, bm, cm, h0):
    b, L = x.shape[:2]
    G, R, P, N = SSD_GROUPS, SSD_HEADS // SSD_GROUPS, SSD_HEADDIM, SSD_STATE
    c = min(SSD_CHUNK, L)
    npad = (-L) % c
    x, dt, bm, cm = [_pad_time(t, npad) for t in (x, dt, bm, cm)]
    nc = (L + npad) // c
    x = x.reshape(b, nc, c, G, R, P)
    dt = dt.reshape(b, nc, c, G, R)
    bm = bm.reshape(b, nc, c, G, N)
    cm = cm.reshape(b, nc, c, G, N)
    acs = jnp.cumsum(dt * a.reshape(G, R), axis=2)
    xdt = x * dt[..., None]
    mask = jnp.tril(jnp.ones((c, c), dtype=bool))[None, None, :, :, None, None]
    diff = acs[:, :, :, None] - acs[:, :, None, :]
    decay = jnp.exp(jnp.where(mask, diff, -jnp.inf))
    cb = jnp.einsum('bctgn,bcsgn->bctsg', cm, bm)
    y_intra = jnp.einsum('bctsg,bctsgr,bcsgrp->bctgrp', cb, decay, xdt)
    dec_end = jnp.exp(acs[:, :, -1:] - acs)
    chunk_decay = jnp.exp(acs[:, :, -1])
    dec_in = jnp.exp(acs)

    def step(h, inp):
        b_c, c_c, x_c, de_c, di_c, dc_c = inp
        y_int = jnp.einsum('btgn,bgrpn,btgr->btgrp', c_c, h, di_c)
        h_new = h * dc_c[..., None, None] + jnp.einsum('bsgn,bsgr,bsgrp->bgrpn', b_c, de_c, x_c)
        return h_new, y_int

    mv = lambda t: jnp.moveaxis(t, 1, 0)
    h_fin, y_inter = lax.scan(step, h0.reshape(b, G, R, P, N),
                              (mv(bm), mv(cm), mv(xdt), mv(dec_end), mv(dec_in), mv(chunk_decay)))
    y = y_intra + jnp.moveaxis(y_inter, 0, 1)
    y = y.reshape(b, nc * c, SSD_HEADS, P)[:, :L]
    return y, h_fin.reshape(b, SSD_HEADS, P, N)


def _gla_chunked(q, k, v, logf, s0):
    b, L, H, K = q.shape
    V = v.shape[-1]
    c = min(HG_CHUNK, L)
    npad = (-L) % c
    q, k, v, logf = [_pad_time(t, npad) for t in (q, k, v, logf)]
    nc = (L + npad) // c
    q = q.reshape(b, nc, c, H, K)
    k = k.reshape(b, nc, c, H, K)
    v = v.reshape(b, nc, c, H, V)
    bcum = jnp.cumsum(logf.reshape(b, nc, c, H, K), axis=2)
    qe = q * jnp.exp(bcum)
    ke = k * jnp.exp(-bcum)
    mask = jnp.tril(jnp.ones((c, c), dtype=bool))
    att = jnp.where(mask, jnp.einsum('bcthk,bcshk->bchts', qe, ke), 0.0)
    o_intra = jnp.einsum('bchts,bcshv->bcthv', att, v)
    kd = k * jnp.exp(bcum[:, :, -1:] - bcum)
    chunk_decay = jnp.exp(bcum[:, :, -1])

    def step(S, inp):
        qe_c, kd_c, v_c, dc_c = inp
        o_int = jnp.einsum('bthk,bhkv->bthv', qe_c, S)
        S_new = S * dc_c[..., None] + jnp.einsum('bshk,bshv->bhkv', kd_c, v_c)
        return S_new, o_int

    mv = lambda t: jnp.moveaxis(t, 1, 0)
    s_fin, o_inter = lax.scan(step, s0, (mv(qe), mv(kd), mv(v), mv(chunk_decay)))
    o = o_intra + jnp.moveaxis(o_inter, 0, 1)
    return o.reshape(b, nc * c, H, V)[:, :L], s_fin


def _mixer(h, conv0, ssm0, hg0, lb, w_in, conv_w, conv_b, dt_bias, a_log, d_skip, ssd_norm, hg_norm, w_out):
    b, L, _ = h.shape
    f32 = jnp.float32
    proj = (h @ w_in).astype(f32)
    sizes = [SSD_DINNER, CONV_DIM, SSD_HEADS, HG_HEADS * HG_DK, HG_HEADS * HG_DK, HG_WIDTH, HG_WIDTH]
    points = [int(v) for v in np.cumsum(sizes)[:-1]]
    z, xbc, dt_raw, q, fr, iv, og = jnp.split(proj, points, axis=-1)
    xbc_full = jnp.concatenate([conv0.astype(f32), xbc], axis=1)
    cw = conv_w.astype(f32)
    conv = conv_b.astype(f32) + sum(cw[j] * xbc_full[:, j:j + L] for j in range(CONV_W))
    conv = jax.nn.silu(conv)
    new_conv = xbc_full[:, -(CONV_W - 1):]
    xs, bm, cm = jnp.split(conv, [SSD_DINNER, SSD_DINNER + SSD_GROUPS * SSD_STATE], axis=-1)
    xs = xs.reshape(b, L, SSD_HEADS, SSD_HEADDIM)
    bm = bm.reshape(b, L, SSD_GROUPS, SSD_STATE)
    cm = cm.reshape(b, L, SSD_GROUPS, SSD_STATE)
    dt = jax.nn.softplus(dt_raw + dt_bias.astype(f32))
    a = -jnp.exp(a_log.astype(f32))
    y, new_ssm = _ssd_chunked(xs, dt, a, bm, cm, ssm0.astype(f32))
    y = y + d_skip.astype(f32)[:, None] * xs
    yg = (y.reshape(b, L, SSD_DINNER) * jax.nn.silu(z)).reshape(b, L, SSD_GROUPS, SSD_DINNER // SSD_GROUPS)
    yg = yg * lax.rsqrt(jnp.mean(yg * yg, axis=-1, keepdims=True) + EPS)
    y_ssd = yg.reshape(b, L, SSD_DINNER) * ssd_norm.astype(f32)
    f = lb + (1.0 - lb) * jax.nn.sigmoid(fr)
    logf = jnp.log(f).reshape(b, L, HG_HEADS, HG_DK)
    kk = (1.0 - f).reshape(b, L, HG_HEADS, HG_DK)
    qq = jax.nn.silu(q).reshape(b, L, HG_HEADS, HG_DK)
    vv = iv.reshape(b, L, HG_HEADS, HG_DV)
    o, new_hg = _gla_chunked(qq, kk, vv, logf, hg0.astype(f32))
    o = o * lax.rsqrt(jnp.mean(o * o, axis=-1, keepdims=True) + EPS)
    o = o.reshape(b, L, HG_WIDTH) * hg_norm.astype(f32) * jax.nn.silu(og)
    mixed = jnp.concatenate([y_ssd, o], axis=-1).astype(h.dtype) @ w_out
    return mixed, new_conv, new_ssm, new_hg


def _layer(x, p, conv0, ssm0, hg0, lb, lw):
    (n_f1, w_f1u, w_f1d, n_mix, w_in, conv_w, conv_b, dt_bias, a_log, d_skip, ssd_norm, hg_norm, w_out,
     n_f2, w_f2u, w_f2d, n_ple, w_ple_gate, w_ple_proj, ple_post) = lw
    x = x + 0.5 * _swiglu(_rmsnorm(x, n_f1), w_f1u, w_f1d)
    m, new_conv, new_ssm, new_hg = _mixer(_rmsnorm(x, n_mix), conv0, ssm0, hg0, lb, w_in, conv_w, conv_b,
                                          dt_bias, a_log, d_skip, ssd_norm, hg_norm, w_out)
    x = x + m.astype(x.dtype)
    x = x + 0.5 * _swiglu(_rmsnorm(x, n_f2), w_f2u, w_f2d)
    gate = jax.nn.sigmoid((_rmsnorm(x, n_ple) @ w_ple_gate).astype(jnp.float32))
    e = _rmsnorm(p.astype(x.dtype) @ w_ple_proj, ple_post).astype(jnp.float32)
    x = x + (gate * e).astype(x.dtype)
    return x, new_conv, new_ssm, new_hg


def setup_inputs(seed: int = 0) -> dict:
    key = jax.random.key(seed)
    ks = iter(jax.random.split(key, 40))
    f32 = jnp.float32
    nrm = lambda shape, s: jax.random.normal(next(ks), shape, f32) * s
    gain = lambda shape: 1.0 + nrm(shape, 0.02)
    dt0 = jnp.exp(jax.random.uniform(next(ks), (DEPTH, SSD_HEADS), f32, np.log(1e-3), np.log(1e-1)))
    return {
        "x_prompt": nrm((BATCH, SEQ, D_MODEL), 1.0),
        "x_sample": nrm((DEC_BATCH, DEC_SEQ, D_MODEL), 1.0),
        "state_conv": nrm((DEPTH, DEC_BATCH, CONV_W - 1, CONV_DIM), 1.0),
        "state_ssm": nrm((DEPTH, DEC_BATCH, SSD_HEADS, SSD_HEADDIM, SSD_STATE), 0.1),
        "state_hgrn": nrm((DEPTH, DEC_BATCH, HG_HEADS, HG_DK, HG_DV), 0.3),
        "p_prompt": nrm((DEPTH, BATCH, SEQ, PLE_DIM), 1.0),
        "p_sample": nrm((DEPTH, DEC_BATCH, DEC_SEQ, PLE_DIM), 1.0),
        "norm_ffn1": gain((DEPTH, D_MODEL)),
        "w_ffn1_up": nrm((DEPTH, D_MODEL, 2 * D_FF), D_MODEL ** -0.5),
        "w_ffn1_down": nrm((DEPTH, D_FF, D_MODEL), D_FF ** -0.5),
        "norm_mix": gain((DEPTH, D_MODEL)),
        "w_in": nrm((DEPTH, D_MODEL, D_IN_PROJ), D_MODEL ** -0.5),
        "conv_w": nrm((DEPTH, CONV_W, CONV_DIM), CONV_W ** -0.5),
        "conv_b": nrm((DEPTH, CONV_DIM), 0.02),
        "dt_bias": dt0 + jnp.log(-jnp.expm1(-dt0)),
        "a_log": jnp.log(jax.random.uniform(next(ks), (DEPTH, SSD_HEADS), f32, 1.0, 16.0)),
        "d_skip": gain((DEPTH, SSD_HEADS)),
        "ssd_norm": gain((DEPTH, SSD_DINNER)),
        "hg_lb_logits": nrm((DEPTH + 1, HG_HEADS * HG_DK), 0.1),
        "hg_norm": gain((DEPTH, HG_WIDTH)),
        "w_out": nrm((DEPTH, D_MIX, D_MODEL), D_MIX ** -0.5),
        "norm_ffn2": gain((DEPTH, D_MODEL)),
        "w_ffn2_up": nrm((DEPTH, D_MODEL, 2 * D_FF), D_MODEL ** -0.5),
        "w_ffn2_down": nrm((DEPTH, D_FF, D_MODEL), D_FF ** -0.5),
        "norm_ple": gain((DEPTH, D_MODEL)),
        "w_ple_gate": nrm((DEPTH, D_MODEL, D_MODEL), D_MODEL ** -0.5),
        "w_ple_proj": nrm((DEPTH, PLE_DIM, D_MODEL), PLE_DIM ** -0.5),
        "ple_post_norm": gain((DEPTH, D_MODEL)),
        "norm_final": gain((D_MODEL,)),
    }


def reference(x_prompt, x_sample, state_conv, state_ssm, state_hgrn, p_prompt, p_sample,
              norm_ffn1, w_ffn1_up, w_ffn1_down, norm_mix, w_in, conv_w, conv_b, dt_bias, a_log, d_skip,
              ssd_norm, hg_lb_logits, hg_norm, w_out, norm_ffn2, w_ffn2_up, w_ffn2_down,
              norm_ple, w_ple_gate, w_ple_proj, ple_post_norm, norm_final):
    f32 = jnp.float32
    bp = x_prompt.shape[0]
    lb_all = jnp.cumsum(jax.nn.softmax(hg_lb_logits.astype(f32), axis=0), axis=0)
    xp, xs = x_prompt, x_sample
    conv_p, ssm_p, hg_p, conv_s, ssm_s, hg_s = [], [], [], [], [], []
    for i in range(DEPTH):
        lw = (norm_ffn1[i], w_ffn1_up[i], w_ffn1_down[i], norm_mix[i], w_in[i], conv_w[i], conv_b[i],
              dt_bias[i], a_log[i], d_skip[i], ssd_norm[i], hg_norm[i], w_out[i],
              norm_ffn2[i], w_ffn2_up[i], w_ffn2_down[i], norm_ple[i], w_ple_gate[i], w_ple_proj[i],
              ple_post_norm[i])
        lb = lb_all[i]
        xp, c_p, s_p, h_p = _layer(xp, p_prompt[i],
                                   jnp.zeros((bp, CONV_W - 1, CONV_DIM), f32),
                                   jnp.zeros((bp, SSD_HEADS, SSD_HEADDIM, SSD_STATE), f32),
                                   jnp.zeros((bp, HG_HEADS, HG_DK, HG_DV), f32), lb, lw)
        xs, c_s, s_s, h_s = _layer(xs, p_sample[i], state_conv[i], state_ssm[i], state_hgrn[i], lb, lw)
        conv_p.append(c_p.astype(state_conv.dtype))
        ssm_p.append(s_p.astype(state_ssm.dtype))
        hg_p.append(h_p.astype(state_hgrn.dtype))
        conv_s.append(c_s.astype(state_conv.dtype))
        ssm_s.append(s_s.astype(state_ssm.dtype))
        hg_s.append(h_s.astype(state_hgrn.dtype))
    y_prompt = _rmsnorm(xp, norm_final)
    y_sample = _rmsnorm(xs, norm_final)
    return (y_prompt, y_sample, jnp.stack(conv_p), jnp.stack(ssm_p), jnp.stack(hg_p),
            jnp.stack(conv_s), jnp.stack(ssm_s), jnp.stack(hg_s))
```

```cpp
#include <hip/hip_runtime.h>
#include <hip/hip_cooperative_groups.h>
#include <cstdio>
#include <cstdint>
namespace pg8 {
#define PG8_LAS __attribute__((address_space(3)))
typedef unsigned short bf16_t;
typedef short bf16x8 __attribute__((ext_vector_type(8)));
typedef float f32x4 __attribute__((ext_vector_type(4)));
typedef unsigned u32x4 __attribute__((ext_vector_type(4)));
constexpr int BM = 256, BK = 64, HALF = 128, HTB = HALF * BK * 2  , STAGE_BYTES = 8 * HTB, NXCD = 8, WGM = 8;

__host__ __device__ __forceinline__ int lds_byte(int r, int c) { const int st = (r >> 4) * 2 + (c >> 5), rr = r & 15, cc = c & 31, ob = rr * 64 + cc * 2; return st * 1024 + (ob ^ (((ob >> 9) & 1) << 5)); }
__host__ __device__ __forceinline__ void stage_rc(int b, int& R, int& C) { const int st = b / 1024, sb = b % 1024, swz = sb ^ (((sb >> 9) & 1) << 5); R = (st >> 1) * 16 + swz / 64; C = (st & 1) * 32 + (swz % 64) / 2; }
__host__ __device__ __forceinline__ int perm32(int rho) { const int n = rho >> 4, i = rho & 15; return 8 * (i >> 2) + 4 * n + (i & 3); }

struct Unit { int pm, pn; };
struct Gemm { const bf16_t* A; const bf16_t* Bt; int M, N, K; };

struct StaticOrder {
    int nM, nN, nwg, G, c;
    __host__ __device__ void init(int M, int N, int G_, int c_) { nM = M / BM; nN = N / BM; nwg = nM * nN; G = G_; c = c_; }
    __host__ __device__ bool next(int i, Unit& u) const {
        const long L = (long)i * G + c; if (L >= nwg) return false;
        int wgid = (int)L; { const int q = nwg / NXCD, r = nwg % NXCD, xcd = wgid % NXCD, off = wgid / NXCD; wgid = (xcd < r ? xcd * (q + 1) : r * (q + 1) + (xcd - r) * q) + off; }
        const int nig = WGM * nN, gid = wgid / nig, fm = gid * WGM, gsz = (nM - fm) < WGM ? (nM - fm) : WGM;
        u.pm = fm + ((wgid % nig) % gsz); u.pn = (wgid % nig) / gsz; return true;
    }
    __device__ __forceinline__ void a_ready(const Unit&) const {}
    __device__ __forceinline__ void done(const Unit&) const {}
};
__device__ __forceinline__ unsigned cvt_pk_bf16(float lo, float hi) { unsigned r; asm volatile("v_cvt_pk_bf16_f32 %0, %1, %2" : "=v"(r) : "v"(lo), "v"(hi)); return r; }
typedef float f32x2 __attribute__((ext_vector_type(2)));
template <class Epi, class Sched, bool ALIGN_EPI = false, bool SP2 = false>
__device__ __forceinline__ void gemm_phase(PG8_LAS unsigned char* lds, const Gemm g, const Sched& S, const Epi& E) {
    const int tid = threadIdx.x, wid = __builtin_amdgcn_readfirstlane(tid >> 6), lane = tid & 63, wr = wid >> 2, wc = wid & 3, fr = lane & 15, fq = lane >> 4;
    const int K = g.K, nt = K / BK;
    unsigned voffA[2], voffB[2];
#pragma unroll
    for (int i = 0; i < 2; ++i) { int R, C; stage_rc(tid * 16 + i * 8192, R, C); const int Rb = Epi::PERM ? ((R & ~31) + perm32(R & 31)) : R;
        voffA[i] = (unsigned)(R * K + C) * 2u; voffB[i] = (unsigned)(Rb * K + C) * 2u; }
    const size_t kstep = (size_t)(BK * 2);
    const size_t hstep = (size_t)HALF * K * 2;
    const size_t tstep = 2 * hstep;
    const unsigned ldsw = (unsigned)wid * 1024u;
    const int aoff = lds_byte(wr * 64 + fr, fq * 8), boff = lds_byte(wc * 32 + fr, fq * 8);
#define PG8_SA(b, h) (((b) * 2 + (h)) * HTB)
#define PG8_SB(b, h) ((4 + (b) * 2 + (h)) * HTB)
#define PG8_STAGE(bufoff, gbase, voff) do { _Pragma("unroll") for (int _i = 0; _i < 2; ++_i) \
        __builtin_amdgcn_global_load_lds((const unsigned*)((const char*)(gbase) + (voff)[_i]), (PG8_LAS unsigned*)(lds + (bufoff) + ldsw + _i * 8192), 16, 0, 0); } while (0)
#define PG8_LDA(dst, b, h) do { _Pragma("unroll") for (int m = 0; m < 4; ++m) _Pragma("unroll") for (int k = 0; k < 2; ++k) dst[m][k] = *(const PG8_LAS bf16x8*)(lds + PG8_SA(b, h) + aoff + m * 2048 + k * 1024); } while (0)
#define PG8_LDB(dst, b, h) do { _Pragma("unroll") for (int n = 0; n < 2; ++n) _Pragma("unroll") for (int k = 0; k < 2; ++k) dst[n][k] = *(const PG8_LAS bf16x8*)(lds + PG8_SB(b, h) + boff + n * 2048 + k * 1024); } while (0)
#define PG8_MMA(ai, bj, At, Bt) do { __builtin_amdgcn_s_setprio(1); _Pragma("unroll") for (int m = 0; m < 4; ++m) _Pragma("unroll") for (int n = 0; n < 2; ++n) _Pragma("unroll") for (int k = 0; k < 2; ++k) \
        acc[ai][bj][m][n] = __builtin_amdgcn_mfma_f32_16x16x32_bf16(Bt[n][k], At[m][k], acc[ai][bj][m][n], 0, 0, 0); __builtin_amdgcn_s_setprio(0); } while (0)
#define PG8_WAIT_V(n) asm volatile("s_waitcnt vmcnt(" #n ")" ::: "memory")
#define PG8_WAIT_L(n) asm volatile("s_waitcnt lgkmcnt(" #n ")" ::: "memory")
#define PG8_BAR __builtin_amdgcn_s_barrier()
#define PG8_SCHED __builtin_amdgcn_sched_barrier(0)
    Unit cur, nxt; int ui = 0;
    if (!S.next(0, cur)) return;
    f32x4 acc[2][2][4][2];
#pragma unroll
    for (int a = 0; a < 2; ++a)
#pragma unroll
        for (int b = 0; b < 2; ++b)
#pragma unroll
            for (int m = 0; m < 4; ++m)
#pragma unroll
                for (int n = 0; n < 2; ++n) acc[a][b][m][n] = (f32x4){0.f, 0.f, 0.f, 0.f};
    bf16x8 At[4][2], B0[2][2], B1[2][2];
    const char* cA = (const char*)g.A + (size_t)cur.pm * tstep; const char* cB = (const char*)g.Bt + (size_t)cur.pn * tstep;
    S.a_ready(cur);
    if constexpr (SP2) {
        PG8_STAGE(PG8_SB(0, 0), cB, voffB); PG8_STAGE(PG8_SB(0, 1), cB + hstep, voffB); PG8_STAGE(PG8_SA(0, 0), cA, voffA); PG8_STAGE(PG8_SA(0, 1), cA + hstep, voffA);
        if (wr == 1) PG8_BAR;
        PG8_WAIT_V(2); PG8_BAR;
        PG8_STAGE(PG8_SB(1, 0), cB + kstep, voffB); PG8_STAGE(PG8_SA(1, 0), cA + kstep, voffA); PG8_STAGE(PG8_SB(1, 1), cB + hstep + kstep, voffB);
        PG8_WAIT_V(6); PG8_BAR;
    } else {
        PG8_STAGE(PG8_SB(0, 0), cB, voffB); PG8_STAGE(PG8_SA(0, 0), cA, voffA); PG8_STAGE(PG8_SB(0, 1), cB + hstep, voffB); PG8_STAGE(PG8_SA(0, 1), cA + hstep, voffA);
        if (wr == 1) PG8_BAR;
        PG8_WAIT_V(4); PG8_BAR;
        PG8_STAGE(PG8_SB(1, 0), cB + kstep, voffB); PG8_STAGE(PG8_SA(1, 0), cA + kstep, voffA); PG8_STAGE(PG8_SB(1, 1), cB + hstep + kstep, voffB);
        PG8_WAIT_V(6); PG8_BAR;
    }
    for (;;) {
        const bool has_next = S.next(ui + 1, nxt);
        const char* nA = has_next ? (const char*)g.A + (size_t)nxt.pm * tstep : cA; const char* nB = has_next ? (const char*)g.Bt + (size_t)nxt.pn * tstep : cB;
        for (int t = 0; t < nt; t += 2) {
            const bool last = (t == nt - 2);
            const char* a1 = cA + (size_t)(t + 1) * kstep;
            const char* a2 = last ? nA : cA + (size_t)(t + 2) * kstep; const char* b2 = last ? nB : cB + (size_t)(t + 2) * kstep;
            const char* a3 = a2 + kstep; const char* b3 = b2 + kstep;
            if (last && has_next) S.a_ready(nxt);
            if constexpr (SP2) {
            PG8_LDB(B0, 0, 0); PG8_LDB(B1, 0, 1); PG8_SCHED; PG8_LDA(At, 0, 0); PG8_STAGE(PG8_SA(1, 1), a1 + hstep, voffA);
            PG8_WAIT_V(8); PG8_WAIT_L(0); PG8_BAR; PG8_MMA(0, 0, At, B0); PG8_MMA(0, 1, At, B1); PG8_BAR; PG8_SCHED;
            PG8_LDA(At, 0, 1); PG8_STAGE(PG8_SB(0, 0), b2, voffB); PG8_STAGE(PG8_SB(0, 1), b2 + hstep, voffB); PG8_STAGE(PG8_SA(0, 0), a2, voffA);
            PG8_WAIT_V(8); PG8_WAIT_L(0); PG8_BAR; PG8_MMA(1, 0, At, B0); PG8_MMA(1, 1, At, B1); PG8_BAR; PG8_SCHED;
            PG8_LDB(B0, 1, 0); PG8_LDB(B1, 1, 1); PG8_SCHED; PG8_LDA(At, 1, 0); PG8_STAGE(PG8_SA(0, 1), a2 + hstep, voffA);
            PG8_WAIT_V(8); PG8_WAIT_L(0); PG8_BAR; PG8_MMA(0, 0, At, B0); PG8_MMA(0, 1, At, B1); PG8_BAR; PG8_SCHED;
            PG8_LDA(At, 1, 1); PG8_STAGE(PG8_SB(1, 0), b3, voffB); PG8_STAGE(PG8_SB(1, 1), b3 + hstep, voffB); PG8_STAGE(PG8_SA(1, 0), a3, voffA);
            PG8_WAIT_V(8); PG8_WAIT_L(0); PG8_BAR; PG8_MMA(1, 0, At, B0); PG8_MMA(1, 1, At, B1); PG8_BAR; PG8_SCHED;
            } else {
            PG8_LDB(B0, 0, 0); PG8_SCHED; PG8_LDA(At, 0, 0); PG8_STAGE(PG8_SA(1, 1), a1 + hstep, voffA);
            PG8_WAIT_L(8); PG8_BAR; PG8_WAIT_L(0); PG8_MMA(0, 0, At, B0); PG8_BAR; PG8_SCHED;
            PG8_LDB(B1, 0, 1); PG8_STAGE(PG8_SB(0, 0), b2, voffB);
            PG8_BAR; PG8_WAIT_L(0); PG8_MMA(0, 1, At, B1); PG8_BAR;
            PG8_LDA(At, 0, 1); PG8_STAGE(PG8_SA(0, 0), a2, voffA);
            PG8_BAR; PG8_WAIT_L(0); PG8_MMA(1, 0, At, B0); PG8_BAR; PG8_SCHED;
            PG8_STAGE(PG8_SB(0, 1), b2 + hstep, voffB);
            PG8_WAIT_V(6); PG8_BAR; PG8_MMA(1, 1, At, B1); PG8_BAR;
            PG8_LDB(B0, 1, 0); PG8_SCHED; PG8_LDA(At, 1, 0); PG8_STAGE(PG8_SA(0, 1), a2 + hstep, voffA);
            PG8_WAIT_L(8); PG8_BAR; PG8_WAIT_L(0); PG8_MMA(0, 0, At, B0); PG8_BAR; PG8_SCHED;
            PG8_LDB(B1, 1, 1); PG8_STAGE(PG8_SB(1, 0), b3, voffB);
            PG8_BAR; PG8_WAIT_L(0); PG8_MMA(0, 1, At, B1); PG8_BAR;
            PG8_LDA(At, 1, 1); PG8_STAGE(PG8_SA(1, 0), a3, voffA);
            PG8_BAR; PG8_WAIT_L(0); PG8_MMA(1, 0, At, B0); PG8_BAR; PG8_SCHED;
            PG8_STAGE(PG8_SB(1, 1), b3 + hstep, voffB);
            PG8_WAIT_V(6); PG8_BAR; PG8_MMA(1, 1, At, B1); PG8_BAR;
            }
        }
        if constexpr (ALIGN_EPI) { if (wr == 0) PG8_BAR; }
        if constexpr (!Epi::AFTER_DRAIN) { E(acc, cur, wr, wc, fr, fq); S.done(cur); }
        if (!has_next) break;
#pragma unroll
        for (int a = 0; a < 2; ++a)
#pragma unroll
            for (int b = 0; b < 2; ++b)
#pragma unroll
                for (int m = 0; m < 4; ++m)
#pragma unroll
                    for (int n = 0; n < 2; ++n) acc[a][b][m][n] = (f32x4){0.f, 0.f, 0.f, 0.f};
        cur = nxt; cA = nA; cB = nB; ++ui;
        if constexpr (ALIGN_EPI) { if (wr == 1) PG8_BAR; }
    }
    PG8_WAIT_V(0);
    if constexpr (!ALIGN_EPI) { if (wr == 0) PG8_BAR; }
    PG8_BAR;
    if constexpr (Epi::AFTER_DRAIN) { E.fused(acc, cur, wr, wc, fr, fq, lds, wid, lane); S.done(cur); }
#undef PG8_SA
#undef PG8_SB
#undef PG8_STAGE
#undef PG8_LDA
#undef PG8_LDB
#undef PG8_MMA
#undef PG8_WAIT_V
#undef PG8_WAIT_L
#undef PG8_BAR
#undef PG8_SCHED
}
}
#define GAS __attribute__((address_space(1)))
#define LAS __attribute__((address_space(3)))
typedef unsigned short bf16;
typedef unsigned v4u __attribute__((ext_vector_type(4)));
typedef float f32x4 __attribute__((ext_vector_type(4)));
typedef short bf16x8 __attribute__((ext_vector_type(8)));
typedef GAS unsigned gu32;
typedef GAS unsigned long long gu64;
#define RLX_AGENT __ATOMIC_RELAXED, __HIP_MEMORY_SCOPE_AGENT
#define LDS_WAIT() asm volatile("s_waitcnt lgkmcnt(0)" ::: "memory")
#define VM_WAIT() asm volatile("s_waitcnt vmcnt(0)" ::: "memory")
__device__ __forceinline__ unsigned long long rt() { return __builtin_amdgcn_s_memrealtime(); }
__device__ __forceinline__ unsigned f2bf(float f) { unsigned u = __builtin_bit_cast(unsigned, f); return (u + 0x7fffu + ((u >> 16) & 1u)) >> 16; }
__device__ __forceinline__ unsigned pk2(float lo, float hi) { return f2bf(lo) | (f2bf(hi) << 16); }
#define XB_TMO      128
#define XB_XCNT(j)  (256  + 64 * (j))
#define XB_XSUB(j)  (1280 + 64 * (j))
#define XB_XGEN(j)  (2304 + 64 * (j))
#define XB_TOP      3328
#define XB_TOPGEN   3392
#define XCD_BAR_WORDS 3456
#define XB_SPIN_CAP (1u << 18)

__device__ __forceinline__ unsigned xb_ld(unsigned* p)              { return __hip_atomic_load(p, __ATOMIC_RELAXED, __HIP_MEMORY_SCOPE_AGENT); }
__device__ __forceinline__ unsigned xb_add(unsigned* p, unsigned v) { return __hip_atomic_fetch_add(p, v, __ATOMIC_RELAXED, __HIP_MEMORY_SCOPE_AGENT); }
__device__ __forceinline__ unsigned xb_xcc_id() { return (unsigned)__builtin_amdgcn_s_getreg((3 << 11) | 20) & 0xFu; }
#define XB_SPIN(cond, bar) do { unsigned _sp = 0; while (cond) { __builtin_amdgcn_s_sleep(1); \
    if ((++_sp & 255u) == 0u) { if (xb_ld(&(bar)[XB_TMO])) break; if (_sp > XB_SPIN_CAP) { atomicAdd(&(bar)[XB_TMO], 1u); break; } } } } while (0)

struct XcdBarrier {
    unsigned* bar; unsigned x;
    volatile LAS unsigned* st;
};

__device__ __forceinline__ XcdBarrier xcd_barrier_post(unsigned* bar, volatile LAS unsigned* st) {
    XcdBarrier b; b.bar = bar; b.x = xb_xcc_id(); b.st = st;
    if (threadIdx.x == 0) (void)xb_add(&bar[XB_XCNT(b.x)], 1u);
    return b;
}
__device__ __forceinline__ void xcd_barrier_complete(unsigned* bar, unsigned x, unsigned& nloc, unsigned& nx) {
    const unsigned G = gridDim.x * gridDim.y * gridDim.z;
    unsigned sum, cnt, mine, sp = 0u;
    for (;;) {
        sum = 0u; cnt = 0u; mine = 0u;
#pragma unroll
        for (unsigned j = 0; j < 16; ++j) { const unsigned c = xb_ld(&bar[XB_XCNT(j)]); sum += c; cnt += (c > 0u) ? 1u : 0u; mine = (j == x) ? c : mine; }
        if (sum == G) break;
        __builtin_amdgcn_s_sleep(1);
        if ((++sp & 255u) == 0u) { if (xb_ld(&bar[XB_TMO])) break; if (sp > XB_SPIN_CAP) { atomicAdd(&bar[XB_TMO], 1u); break; } }
    }
    nloc = mine > 0u ? mine : 1u; nx = cnt > 0u ? cnt : 1u;
}

__device__ __forceinline__ void xcd_barrier(const XcdBarrier& b) {
    asm volatile("s_waitcnt vmcnt(0)" ::: "memory");
    __syncthreads();
    if (threadIdx.x == 0) {
        unsigned* bar = b.bar;
        __builtin_amdgcn_s_waitcnt(0);
        unsigned nloc = b.st[0], nx = b.st[1];
        if (nloc == 0u) { xcd_barrier_complete(bar, b.x, nloc, nx); b.st[0] = nloc; b.st[1] = nx; }
        const unsigned old = xb_add(&bar[XB_XSUB(b.x)], 1u);
        const unsigned gen = old / nloc;
        if (old + 1u == (gen + 1u) * nloc) {
            __builtin_amdgcn_fence(__ATOMIC_RELEASE, "agent");
            asm volatile("s_waitcnt vmcnt(0)" ::: "memory");
            const unsigned og = xb_add(&bar[XB_TOP], 1u);
            const unsigned tg = og / nx;
            if (og + 1u == (tg + 1u) * nx) xb_add(&bar[XB_TOPGEN], 1u);
            else XB_SPIN(xb_ld(&bar[XB_TOPGEN]) == tg, bar);
            __builtin_amdgcn_fence(__ATOMIC_ACQUIRE, "agent");
            xb_add(&bar[XB_XGEN(b.x)], 1u);
            asm volatile("s_waitcnt vmcnt(0)" ::: "memory");
        } else {
            XB_SPIN(xb_ld(&bar[XB_XGEN(b.x)]) == gen, bar);
            __builtin_amdgcn_fence(__ATOMIC_ACQUIRE, "agent");
            asm volatile("s_waitcnt vmcnt(0)" ::: "memory");
        }
    }
    __syncthreads();
}

constexpr int DM = 1024, NBP = 8, SEQ = 2048, NBS = 128, DSEQ = 4;
constexpr int MP = NBP * SEQ, MS = NBS * DSEQ, MT = MP + MS;
constexpr int PLE = 256, DFF = 2816;
constexpr int SH = 16, SP = 64, SN = 128, CONVD = 1536;
constexpr int HH = 8, HK = 128, HV = 128;
constexpr int DIN = 6672, DINP = 6912;
constexpr float EPS = 1e-6f;
constexpr int NSEQ = NBP + NBS;
constexpr int NWAVES = 8, NTHR = 512;
constexpr size_t O_Y = 0, O_CP = 17301504, O_SP = 17338368, O_HP = 18386944, O_CS = 19435520, O_SS = 20025344, O_HS = 36802560, O_END = 53579776;
constexpr size_t MiB = 1u << 20;
constexpr size_t WS_CTL = 0, CTL_ZERO_BYTES = 1 * MiB;
constexpr size_t WS_STATS = 1 * MiB;
constexpr size_t WS_W1U = 4 * MiB, WS_W1D = 16 * MiB, WS_WIN = 22 * MiB, WS_WOUT = 36 * MiB, WS_W2U = 40 * MiB, WS_W2D = 52 * MiB, WS_WG = 58 * MiB, WS_WP = 60 * MiB;
constexpr size_t WS_XB = 64 * MiB, WS_PB = 98 * MiB, WS_XR = 108 * MiB, WS_ACT = 176 * MiB;
constexpr size_t WS_ZS = 268 * MiB, WS_XBC = 302 * MiB, WS_DT = 352 * MiB, WS_QS = 354 * MiB, WS_LOGF = 388 * MiB, WS_KK = 454 * MiB, WS_VV = 488 * MiB, WS_OGS = 522 * MiB;
constexpr size_t WS_MIX = 556 * MiB, WS_E = 622 * MiB, WS_END = 688 * MiB;
static_assert(WS_W1U + (size_t)5632 * 1024 * 2 <= WS_W1D && WS_W1D + (size_t)1024 * 2816 * 2 <= WS_WIN && WS_WIN + (size_t)DINP * 1024 * 2 <= WS_WOUT && WS_WOUT + (size_t)1024 * 2048 * 2 <= WS_W2U, "ws map (weights)");
static_assert(WS_XB + (size_t)MT * 1024 * 2 <= WS_PB && WS_PB + (size_t)MT * 256 * 2 <= WS_XR && WS_XR + (size_t)MT * 1024 * 4 <= WS_ACT && WS_ACT + (size_t)MT * DFF * 2 <= WS_ZS, "ws map (acts)");
static_assert(WS_ZS + (size_t)MT * 1024 * 2 <= WS_XBC && WS_XBC + (size_t)MT * 1536 * 2 <= WS_DT && WS_DT + (size_t)MT * 16 * 4 <= WS_QS && WS_QS + (size_t)MT * 1024 * 2 <= WS_LOGF && WS_LOGF + (size_t)MT * 1024 * 4 <= WS_KK, "ws map (proj)");
static_assert(WS_MIX + (size_t)MT * 2048 * 2 <= WS_E && WS_E + (size_t)MT * 1024 * 4 <= WS_END, "ws map (mix)");
constexpr int ST_SS0 = 0, ST_SS1 = MT, ST_SS2 = 2 * MT, ST_SS3 = 3 * MT, ST_SS4 = 4 * MT, ST_SSE = 5 * MT, ST_SSD = 6 * MT, ST_SHG = 8 * MT, ST_LB = 16 * MT, ST_END = 16 * MT + 1024;
static_assert((size_t)ST_END * 4 <= 3 * MiB, "stats region");
constexpr int CW_BAR = 4096;
constexpr int RING_BYTES = 131072, LDSCTL_OFF = RING_BYTES, MISC_OFF = LDSCTL_OFF + 320, LDS_BYTES = 147456;

__device__ __forceinline__ float bf2f(bf16 b) { return __builtin_bit_cast(float, (unsigned)b << 16); }
__device__ __forceinline__ float siluf(float x) { return x / (1.0f + __expf(-x)); }
__device__ __forceinline__ float sigmoidf_(float x) { return 1.0f / (1.0f + __expf(-x)); }
__device__ __forceinline__ float softplusf_(float x) { return fmaxf(x, 0.f) + log1pf(__expf(-fabsf(x))); }
__device__ __forceinline__ int tid_op() { int t = threadIdx.x; asm volatile("" : "+v"(t)); return t; }
__device__ __forceinline__ float wave_sum(float v) {
#pragma unroll
    for (int o = 1; o < 64; o <<= 1) v += __shfl_xor(v, o);
    return v;
}

namespace pg8 {
struct EpiUp {
    static constexpr bool PERM = true, AFTER_DRAIN = false;
    bf16_t* O; const float* ss;
    __device__ __forceinline__ void operator()(const f32x4 (&acc)[2][2][4][2], const Unit& u, int wr, int wc, int fr, int fq) const {
        const int row0 = u.pm * BM + wr * 64 + fr, col0 = u.pn * 128 + wc * 32 + 8 * fq;
#pragma unroll
        for (int ai = 0; ai < 2; ++ai)
#pragma unroll
            for (int m = 0; m < 4; ++m) {
                const int row = row0 + ai * HALF + m * 16;
                const float rs = rsqrtf(ss[row] * (1.0f / DM) + EPS);
                float a[8];
#pragma unroll
                for (int n = 0; n < 2; ++n)
#pragma unroll
                    for (int i = 0; i < 4; ++i) { const float g = acc[ai][0][m][n][i] * rs, uu = acc[ai][1][m][n][i] * rs; a[4 * n + i] = siluf(g) * uu; }
                u32x4 w; w.x = cvt_pk_bf16(a[0], a[1]); w.y = cvt_pk_bf16(a[2], a[3]); w.z = cvt_pk_bf16(a[4], a[5]); w.w = cvt_pk_bf16(a[6], a[7]);
                *(u32x4*)(O + (size_t)row * DFF + col0) = w;
            }
    }
};
struct EpiRes {
    static constexpr bool PERM = true, AFTER_DRAIN = false;
    const float* resP; const float* resS; float* xr; bf16_t* xb; float* ssout; float alpha;
    __device__ __forceinline__ void operator()(const f32x4 (&acc)[2][2][4][2], const Unit& u, int wr, int wc, int fr, int fq) const {
        const int row0 = u.pm * BM + wr * 64 + fr, col0 = u.pn * BM + wc * 32 + 8 * fq;
#pragma unroll
        for (int ai = 0; ai < 2; ++ai)
#pragma unroll
            for (int m = 0; m < 4; ++m) {
                const int row = row0 + ai * HALF + m * 16;
                const float* rp = (row < MP) ? resP + (size_t)row * DM : resS + (size_t)(row - MP) * DM;
                float sq = 0.f;
#pragma unroll
                for (int bj = 0; bj < 2; ++bj) {
                    const int c = col0 + bj * HALF;
                    const f32x4 r0 = *(const f32x4*)(rp + c), r1 = *(const f32x4*)(rp + c + 4);
                    const f32x4 v0 = r0 + acc[ai][bj][m][0] * alpha, v1 = r1 + acc[ai][bj][m][1] * alpha;
                    *(f32x4*)(xr + (size_t)row * DM + c) = v0; *(f32x4*)(xr + (size_t)row * DM + c + 4) = v1;
                    u32x4 w; w.x = cvt_pk_bf16(v0[0], v0[1]); w.y = cvt_pk_bf16(v0[2], v0[3]); w.z = cvt_pk_bf16(v1[0], v1[1]); w.w = cvt_pk_bf16(v1[2], v1[3]);
                    *(u32x4*)(xb + (size_t)row * DM + c) = w;
                    sq += (v0[0] * v0[0] + v0[1] * v0[1]) + (v0[2] * v0[2] + v0[3] * v0[3]) + (v1[0] * v1[0] + v1[1] * v1[1]) + (v1[2] * v1[2] + v1[3] * v1[3]);
                }
                sq += __shfl_xor(sq, 16); sq += __shfl_xor(sq, 32);
                if (fq == 0) atomicAdd(ssout + row, sq);
            }
    }
};
struct EpiIn {
    static constexpr bool PERM = true, AFTER_DRAIN = false;
    const float* ss; bf16_t* zs; bf16_t* xbc; float* dt; bf16_t* qs; float* logf; bf16_t* kk; bf16_t* vv; bf16_t* ogs;
    const float* lb; const float* dt_bias; float* conv_p; float* conv_s;
    __device__ __forceinline__ void operator()(const f32x4 (&acc)[2][2][4][2], const Unit& u, int wr, int wc, int fr, int fq) const {
        const int row0 = u.pm * BM + wr * 64 + fr, pn = u.pn;
#pragma unroll
        for (int ai = 0; ai < 2; ++ai)
#pragma unroll
            for (int m = 0; m < 4; ++m) {
                const int row = row0 + ai * HALF + m * 16;
                const float rs = rsqrtf(ss[row] * (1.0f / DM) + EPS);
#pragma unroll
                for (int bj = 0; bj < 2; ++bj) {
                    float v[8];
#pragma unroll
                    for (int n = 0; n < 2; ++n)
#pragma unroll
                        for (int i = 0; i < 4; ++i) v[4 * n + i] = acc[ai][bj][m][n][i] * rs;
                    const int ct = bj * HALF + wc * 32 + 8 * fq;
                    if (pn < 4) {
                        const int c = pn * 256 + ct;
                        u32x4 w; w.x = cvt_pk_bf16(siluf(v[0]), siluf(v[1])); w.y = cvt_pk_bf16(siluf(v[2]), siluf(v[3])); w.z = cvt_pk_bf16(siluf(v[4]), siluf(v[5])); w.w = cvt_pk_bf16(siluf(v[6]), siluf(v[7]));
                        *(u32x4*)(zs + (size_t)row * DM + c) = w;
                    } else if (pn < 10) {
                        const int c = (pn - 4) * 256 + ct;
                        u32x4 w; w.x = cvt_pk_bf16(v[0], v[1]); w.y = cvt_pk_bf16(v[2], v[3]); w.z = cvt_pk_bf16(v[4], v[5]); w.w = cvt_pk_bf16(v[6], v[7]);
                        *(u32x4*)(xbc + (size_t)row * CONVD + c) = w;
                        float* dst = nullptr;
                        if (row < MP) { const int t = row & (SEQ - 1); if (t >= SEQ - 3) dst = conv_p + ((size_t)(row >> 11) * 3 + (t - (SEQ - 3))) * CONVD + c; }
                        else { const int t = row & 3; if (t >= 1) dst = conv_s + ((size_t)((row - MP) >> 2) * 3 + (t - 1)) * CONVD + c; }
                        if (dst) { *(f32x4*)dst = (f32x4){v[0], v[1], v[2], v[3]}; *(f32x4*)(dst + 4) = (f32x4){v[4], v[5], v[6], v[7]}; }
                    } else if (pn < 14) {
                        const int c = (pn - 10) * 256 + ct;
                        u32x4 w; w.x = cvt_pk_bf16(siluf(v[0]), siluf(v[1])); w.y = cvt_pk_bf16(siluf(v[2]), siluf(v[3])); w.z = cvt_pk_bf16(siluf(v[4]), siluf(v[5])); w.w = cvt_pk_bf16(siluf(v[6]), siluf(v[7]));
                        *(u32x4*)(qs + (size_t)row * DM + c) = w;
                    } else if (pn < 18) {
                        const int c = (pn - 14) * 256 + ct;
                        const f32x4 l0 = *(const f32x4*)(lb + c), l1 = *(const f32x4*)(lb + c + 4);
                        float lf[8], kv[8];
#pragma unroll
                        for (int i = 0; i < 8; ++i) { const float lbv = i < 4 ? l0[i & 3] : l1[i & 3]; const float f = lbv + (1.0f - lbv) * sigmoidf_(v[i]); lf[i] = __logf(f); kv[i] = 1.0f - f; }
                        *(f32x4*)(logf + (size_t)row * DM + c) = (f32x4){lf[0], lf[1], lf[2], lf[3]}; *(f32x4*)(logf + (size_t)row * DM + c + 4) = (f32x4){lf[4], lf[5], lf[6], lf[7]};
                        u32x4 w; w.x = cvt_pk_bf16(kv[0], kv[1]); w.y = cvt_pk_bf16(kv[2], kv[3]); w.z = cvt_pk_bf16(kv[4], kv[5]); w.w = cvt_pk_bf16(kv[6], kv[7]);
                        *(u32x4*)(kk + (size_t)row * DM + c) = w;
                    } else if (pn < 22) {
                        const int c = (pn - 18) * 256 + ct;
                        u32x4 w; w.x = cvt_pk_bf16(v[0], v[1]); w.y = cvt_pk_bf16(v[2], v[3]); w.z = cvt_pk_bf16(v[4], v[5]); w.w = cvt_pk_bf16(v[6], v[7]);
                        *(u32x4*)(vv + (size_t)row * DM + c) = w;
                    } else if (pn < 26) {
                        const int c = (pn - 22) * 256 + ct;
                        u32x4 w; w.x = cvt_pk_bf16(siluf(v[0]), siluf(v[1])); w.y = cvt_pk_bf16(siluf(v[2]), siluf(v[3])); w.z = cvt_pk_bf16(siluf(v[4]), siluf(v[5])); w.w = cvt_pk_bf16(siluf(v[6]), siluf(v[7]));
                        *(u32x4*)(ogs + (size_t)row * DM + c) = w;
                    } else {
                        if (ct < 16) {
                            const f32x4 b0 = *(const f32x4*)(dt_bias + ct), b1 = *(const f32x4*)(dt_bias + ct + 4);
                            f32x4 o0, o1;
#pragma unroll
                            for (int i = 0; i < 4; ++i) { o0[i] = softplusf_(v[i] + b0[i]); o1[i] = softplusf_(v[4 + i] + b1[i]); }
                            *(f32x4*)(dt + (size_t)row * 16 + ct) = o0; *(f32x4*)(dt + (size_t)row * 16 + ct + 4) = o1;
                        }
                    }
                }
            }
    }
};
struct EpiE {
    static constexpr bool PERM = true, AFTER_DRAIN = false;
    float* E; float* sse;
    __device__ __forceinline__ void operator()(const f32x4 (&acc)[2][2][4][2], const Unit& u, int wr, int wc, int fr, int fq) const {
        const int row0 = u.pm * BM + wr * 64 + fr, col0 = u.pn * BM + wc * 32 + 8 * fq;
#pragma unroll
        for (int ai = 0; ai < 2; ++ai)
#pragma unroll
            for (int m = 0; m < 4; ++m) {
                const int row = row0 + ai * HALF + m * 16; float sq = 0.f;
#pragma unroll
                for (int bj = 0; bj < 2; ++bj) {
                    const int c = col0 + bj * HALF; const f32x4 v0 = acc[ai][bj][m][0], v1 = acc[ai][bj][m][1];
                    *(f32x4*)(E + (size_t)row * DM + c) = v0; *(f32x4*)(E + (size_t)row * DM + c + 4) = v1;
                    sq += (v0[0] * v0[0] + v0[1] * v0[1]) + (v0[2] * v0[2] + v0[3] * v0[3]) + (v1[0] * v1[0] + v1[1] * v1[1]) + (v1[2] * v1[2] + v1[3] * v1[3]);
                }
                sq += __shfl_xor(sq, 16); sq += __shfl_xor(sq, 32);
                if (fq == 0) atomicAdd(sse + row, sq);
            }
    }
};
struct EpiGate {
    static constexpr bool PERM = true, AFTER_DRAIN = false;
    const float* ss3; const float* E; const float* sse; const float* post; const float* xr; float* y; float* ss4;
    __device__ __forceinline__ void operator()(const f32x4 (&acc)[2][2][4][2], const Unit& u, int wr, int wc, int fr, int fq) const {
        const int row0 = u.pm * BM + wr * 64 + fr, col0 = u.pn * BM + wc * 32 + 8 * fq;
#pragma unroll
        for (int ai = 0; ai < 2; ++ai)
#pragma unroll
            for (int m = 0; m < 4; ++m) {
                const int row = row0 + ai * HALF + m * 16; float sq = 0.f;
                const float rs = rsqrtf(ss3[row] * (1.0f / DM) + EPS), re = rsqrtf(sse[row] * (1.0f / DM) + EPS);
#pragma unroll
                for (int bj = 0; bj < 2; ++bj) {
                    const int c = col0 + bj * HALF;
#pragma unroll
                    for (int n = 0; n < 2; ++n) {
                        const f32x4 e = *(const f32x4*)(E + (size_t)row * DM + c + 4 * n), pw = *(const f32x4*)(post + c + 4 * n), x = *(const f32x4*)(xr + (size_t)row * DM + c + 4 * n);
                        f32x4 o;
#pragma unroll
                        for (int i = 0; i < 4; ++i) { o[i] = x[i] + sigmoidf_(acc[ai][bj][m][n][i] * rs) * (e[i] * re * pw[i]); sq += o[i] * o[i]; }
                        *(f32x4*)(y + (size_t)row * DM + c + 4 * n) = o;
                    }
                }
                sq += __shfl_xor(sq, 16); sq += __shfl_xor(sq, 32);
                if (fq == 0) atomicAdd(ss4 + row, sq);
            }
    }
};
}

__device__ __forceinline__ void tr_item(const float* W, int K, int Nsrc, int k0, int c0, int nvalid, bf16* WT, int drow0, const float* ks, LAS float* scr, int lane) {
#pragma unroll 8
    for (int i = 0; i < 32; ++i) { const int kk = 2 * i + (lane >> 5), cc = lane & 31;
        float v = (cc < nvalid) ? W[(size_t)(k0 + kk) * Nsrc + c0 + cc] : 0.f; if (ks) v *= ks[kk]; scr[kk * 33 + cc] = v; }
    LDS_WAIT(); asm volatile("" ::: "memory");
    const int c = lane & 7;
#pragma unroll
    for (int j = 0; j < 4; ++j) { const int n = (lane >> 3) + 8 * j; const LAS float* s = scr + (8 * c) * 33 + n;
        v4u o; o.x = pk2(s[0 * 33], s[1 * 33]); o.y = pk2(s[2 * 33], s[3 * 33]); o.z = pk2(s[4 * 33], s[5 * 33]); o.w = pk2(s[6 * 33], s[7 * 33]);
        *(GAS v4u*)(WT + (size_t)(drow0 + n) * K + k0 + 8 * c) = o; }
    LDS_WAIT(); asm volatile("" ::: "memory");
}

struct Args { const float* in[29]; float* out; unsigned char* ws; int ph_lo, ph_hi; };

__device__ __forceinline__ void p0_prologue(const Args& A, LAS unsigned char* lds, int vcu, int G) {
    const int tid = tid_op(), lane = tid & 63, wave = __builtin_amdgcn_readfirstlane(tid >> 6);
    LAS float* scr = (LAS float*)(lds + wave * 16384);
    const int gw = vcu * NWAVES + wave, NGW = G * NWAVES;
    unsigned char* ws = A.ws;
    bf16* W1U = (bf16*)(ws + WS_W1U); bf16* W1D = (bf16*)(ws + WS_W1D); bf16* WIN = (bf16*)(ws + WS_WIN); bf16* WOUT = (bf16*)(ws + WS_WOUT);
    bf16* W2U = (bf16*)(ws + WS_W2U); bf16* W2D = (bf16*)(ws + WS_W2D); bf16* WG = (bf16*)(ws + WS_WG); bf16* WP = (bf16*)(ws + WS_WP);
    constexpr int I_UP = 16 * 176, I_DN = 44 * 32, I_IN = 16 * 216, I_OUT = 32 * 32, I_G = 16 * 32, I_P = 4 * 32;
    constexpr int NITEMS = 2 * I_UP + 2 * I_DN + I_IN + I_OUT + I_G + I_P;
    for (int it = gw; it < NITEMS; it += NGW) {
        int r = it;
        if (r < 2 * I_UP) {
            const int which = r / I_UP; r -= which * I_UP; const int kb = r / 176, nb = r % 176, drow = nb * 32;
            const int t = drow >> 8, rem = drow & 255, h = rem >> 7, i = rem & 127;
            tr_item(which ? A.in[22] : A.in[8], 1024, 2 * DFF, kb * 64, h * DFF + t * 128 + i, 32, which ? W2U : W1U, drow, (which ? A.in[21] : A.in[7]) + kb * 64, scr, lane); continue; }
        r -= 2 * I_UP;
        if (r < 2 * I_DN) { const int which = r / I_DN; r -= which * I_DN; const int kb = r / 32, nb = r % 32;
            tr_item(which ? A.in[23] : A.in[9], DFF, 1024, kb * 64, nb * 32, 32, which ? W2D : W1D, nb * 32, nullptr, scr, lane); continue; }
        r -= 2 * I_DN;
        if (r < I_IN) { const int kb = r / 216, nb = r % 216, drow = nb * 32; int c0, nv = 32;
            if (drow < 2560) c0 = drow; else if (drow < 6656) c0 = drow + 16; else if (drow == 6656) { c0 = 2560; nv = 16; } else { c0 = 0; nv = 0; }
            tr_item(A.in[11], 1024, DIN, kb * 64, c0, nv, WIN, drow, A.in[10] + kb * 64, scr, lane); continue; }
        r -= I_IN;
        if (r < I_OUT) { const int kb = r / 32, nb = r % 32, k0 = kb * 64;
            tr_item(A.in[20], 2048, 1024, k0, nb * 32, 32, WOUT, nb * 32, k0 < 1024 ? A.in[17] + k0 : A.in[19] + (k0 - 1024), scr, lane); continue; }
        r -= I_OUT;
        if (r < I_G) { const int kb = r / 32, nb = r % 32;
            tr_item(A.in[25], 1024, 1024, kb * 64, nb * 32, 32, WG, nb * 32, A.in[24] + kb * 64, scr, lane); continue; }
        r -= I_G;
        { const int kb = r / 32, nb = r % 32; tr_item(A.in[26], PLE, 1024, kb * 64, nb * 32, 32, WP, nb * 32, nullptr, scr, lane); }
    }
    float* stats = (float*)(ws + WS_STATS);
    bf16* XB = (bf16*)(ws + WS_XB); bf16* PB = (bf16*)(ws + WS_PB);
    for (int m = gw; m < MT; m += NGW) {
        const float* xrow = (m < MP) ? A.in[0] + (size_t)m * DM : A.in[1] + (size_t)(m - MP) * DM;
        const GAS f32x4* xr = (const GAS f32x4*)xrow + lane;
        f32x4 v[4]; float s = 0.f;
#pragma unroll
        for (int j = 0; j < 4; ++j) { v[j] = xr[64 * j]; s += (v[j].x * v[j].x + v[j].y * v[j].y) + (v[j].z * v[j].z + v[j].w * v[j].w); }
        s = wave_sum(s);
        if (lane == 0) stats[ST_SS0 + m] = s;
        GAS unsigned long long* o8 = (GAS unsigned long long*)(XB + (size_t)m * DM) + lane;
#pragma unroll
        for (int j = 0; j < 4; ++j) o8[64 * j] = (unsigned long long)pk2(v[j].x, v[j].y) | ((unsigned long long)pk2(v[j].z, v[j].w) << 32);
        const float* prow = (m < MP) ? A.in[5] + (size_t)m * PLE : A.in[6] + (size_t)(m - MP) * PLE;
        const f32x4 pv = ((const GAS f32x4*)prow)[lane];
        ((GAS unsigned long long*)(PB + (size_t)m * PLE))[lane] = (unsigned long long)pk2(pv.x, pv.y) | ((unsigned long long)pk2(pv.z, pv.w) << 32);
    }
    const int gt = vcu * NTHR + tid, NGT = G * NTHR;
    for (int i = gt; i < 15 * MT; i += NGT) stats[MT + i] = 0.f;
    for (int i = gt; i < 1024; i += NGT) stats[ST_LB + i] = 1.0f / (1.0f + __expf(A.in[18][1024 + i] - A.in[18][i]));
}

constexpr int SSD_TC = 32, GLA_TC = 16;
__device__ __forceinline__ void ssd_item(const Args& A, LAS unsigned char* lds, int s, int h) {
    const int tid = tid_op(), p = tid >> 3, nq = tid & 7, g = h >> 3;
    const bool prompt = s < NBP; const int L = prompt ? SEQ : DSEQ; const int rowbase = prompt ? s * SEQ : MP + (s - NBP) * DSEQ;
    unsigned char* ws = A.ws;
    const bf16* XBC = (const bf16*)(ws + WS_XBC); const bf16* ZS = (const bf16*)(ws + WS_ZS); const float* DT = (const float*)(ws + WS_DT);
    bf16* MIX = (bf16*)(ws + WS_MIX); float* stats = (float*)(ws + WS_STATS);
    const float* conv_w = A.in[12]; const float* conv_b = A.in[13]; const float* conv0 = A.in[2];
    LAS float* xs = (LAS float*)lds; LAS float* Bs = xs + SSD_TC * 64; LAS float* Cs = Bs + SSD_TC * 128; LAS float* yo = Cs + SSD_TC * 128; LAS float* dts = yo + SSD_TC * 64;
    float hst[16];
    if (prompt) {
#pragma unroll
        for (int i = 0; i < 16; ++i) hst[i] = 0.f;
    } else { const float* h0 = A.in[3] + ((size_t)(s - NBP) * SH + h) * (SP * SN) + p * SN + nq * 16;
#pragma unroll
        for (int i = 0; i < 4; ++i) { const f32x4 t4 = *(const f32x4*)(h0 + 4 * i); hst[4 * i] = t4.x; hst[4 * i + 1] = t4.y; hst[4 * i + 2] = t4.z; hst[4 * i + 3] = t4.w; } }
    const float a = -__expf(A.in[15][h]), dsk = A.in[16][h];
    for (int t0 = 0; t0 < L; t0 += SSD_TC) {
        const int nT = (L - t0) < SSD_TC ? (L - t0) : SSD_TC;
        __syncthreads();
        for (int idx = tid; idx < nT * 320; idx += NTHR) {
            const int t = idx / 320, c = idx - t * 320;
            const int col = c < 64 ? h * 64 + c : (c < 192 ? 1024 + g * 128 + (c - 64) : 1280 + g * 128 + (c - 192));
            float av = conv_b[col];
#pragma unroll
            for (int j = 0; j < 4; ++j) { const int tt = t0 + t + j - 3; float r;
                if (tt >= 0) r = bf2f(XBC[(size_t)(rowbase + tt) * CONVD + col]); else r = prompt ? 0.f : conv0[((size_t)(s - NBP) * 3 + (3 + tt)) * CONVD + col];
                av += conv_w[j * CONVD + col] * r; }
            const float v = siluf(av);
            if (c < 64) xs[t * 64 + c] = v; else if (c < 192) Bs[t * 128 + (c - 64)] = v; else Cs[t * 128 + (c - 192)] = v;
        }
        if (tid < nT) dts[tid] = DT[(size_t)(rowbase + t0 + tid) * 16 + h];
        __syncthreads();
        for (int t = 0; t < nT; ++t) {
            const float dt = dts[t], dA = __expf(dt * a), xv = xs[t * 64 + p], dx = dt * xv; float y = 0.f;
#pragma unroll
            for (int i = 0; i < 16; ++i) { hst[i] = hst[i] * dA + dx * Bs[t * 128 + nq * 16 + i]; y += hst[i] * Cs[t * 128 + nq * 16 + i]; }
            y += __shfl_xor(y, 1); y += __shfl_xor(y, 2); y += __shfl_xor(y, 4);
            if (nq == 0) yo[t * 64 + p] = y + dsk * xv;
        }
        __syncthreads();
        for (int idx = tid; idx < nT * 64; idx += NTHR) {
            const int t = idx >> 6, pp = idx & 63; const size_t row = (size_t)(rowbase + t0 + t);
            const float v = yo[idx] * bf2f(ZS[row * DM + h * 64 + pp]);
            MIX[row * 2048 + h * 64 + pp] = (bf16)f2bf(v);
            const float sq = wave_sum(v * v);
            if (pp == 0) atomicAdd(stats + ST_SSD + row * 2 + g, sq);
        }
    }
    float* hout = (prompt ? A.out + O_SP + ((size_t)s * SH + h) * (SP * SN) : A.out + O_SS + ((size_t)(s - NBP) * SH + h) * (SP * SN)) + p * SN + nq * 16;
#pragma unroll
    for (int i = 0; i < 4; ++i) *(f32x4*)(hout + 4 * i) = (f32x4){hst[4 * i], hst[4 * i + 1], hst[4 * i + 2], hst[4 * i + 3]};
}
__device__ __forceinline__ void gla_item(const Args& A, LAS unsigned char* lds, int s, int h) {
    const int tid = tid_op(), lane = tid & 63, wave = __builtin_amdgcn_readfirstlane(tid >> 6), kg = tid >> 5, vq = tid & 31;
    const bool prompt = s < NBP; const int L = prompt ? SEQ : DSEQ; const int rowbase = prompt ? s * SEQ : MP + (s - NBP) * DSEQ;
    unsigned char* ws = A.ws;
    const bf16* QS = (const bf16*)(ws + WS_QS); const bf16* KK = (const bf16*)(ws + WS_KK); const bf16* VV = (const bf16*)(ws + WS_VV); const float* LOGF = (const float*)(ws + WS_LOGF);
    bf16* MIX = (bf16*)(ws + WS_MIX); float* stats = (float*)(ws + WS_STATS);
    LAS float* qs = (LAS float*)lds; LAS float* ks = qs + GLA_TC * 128; LAS float* fs = ks + GLA_TC * 128; LAS float* vs = fs + GLA_TC * 128; LAS float* op = vs + GLA_TC * 128;
    float S[8][4];
    if (prompt) {
#pragma unroll
        for (int i = 0; i < 8; ++i)
#pragma unroll
            for (int j = 0; j < 4; ++j) S[i][j] = 0.f;
    } else { const float* s0 = A.in[4] + ((size_t)(s - NBP) * HH + h) * (HK * HV) + (size_t)(kg * 8) * HV + 4 * vq;
#pragma unroll
        for (int i = 0; i < 8; ++i) { const f32x4 t4 = *(const f32x4*)(s0 + i * HV); S[i][0] = t4.x; S[i][1] = t4.y; S[i][2] = t4.z; S[i][3] = t4.w; } }
    for (int t0 = 0; t0 < L; t0 += GLA_TC) {
        const int nT = (L - t0) < GLA_TC ? (L - t0) : GLA_TC;
        __syncthreads();
        for (int idx = tid; idx < nT * 128; idx += NTHR) {
            const int t = idx >> 7, c = idx & 127; const size_t o = (size_t)(rowbase + t0 + t) * DM + h * 128 + c;
            qs[idx] = bf2f(QS[o]); ks[idx] = bf2f(KK[o]); fs[idx] = __expf(LOGF[o]); vs[idx] = bf2f(VV[o]);
        }
        __syncthreads();
        for (int t = 0; t < nT; ++t) {
            const f32x4 v4 = *(const LAS f32x4*)(vs + t * 128 + 4 * vq); f32x4 o4 = (f32x4){0.f, 0.f, 0.f, 0.f};
#pragma unroll
            for (int i = 0; i < 8; ++i) { const int k = t * 128 + kg * 8 + i; const float f = fs[k], kv = ks[k], qv = qs[k];
#pragma unroll
                for (int j = 0; j < 4; ++j) { S[i][j] = f * S[i][j] + kv * v4[j]; o4[j] += qv * S[i][j]; } }
#pragma unroll
            for (int j = 0; j < 4; ++j) o4[j] += __shfl_xor(o4[j], 32);
            if (lane < 32) *(LAS f32x4*)(op + (t * 8 + wave) * 128 + 4 * vq) = o4;
        }
        __syncthreads();
        for (int idx = tid; idx < nT * 128; idx += NTHR) {
            const int t = idx >> 7, c = idx & 127; float o = 0.f;
#pragma unroll
            for (int w = 0; w < 8; ++w) o += op[(t * 8 + w) * 128 + c];
            const size_t row = (size_t)(rowbase + t0 + t);
            MIX[row * 2048 + 1024 + h * 128 + c] = (bf16)f2bf(o);
            const float sq = wave_sum(o * o);
            if (lane == 0) atomicAdd(stats + ST_SHG + row * 8 + h, sq);
        }
    }
    float* sout = (prompt ? A.out + O_HP + ((size_t)s * HH + h) * (HK * HV) : A.out + O_HS + ((size_t)(s - NBP) * HH + h) * (HK * HV)) + (size_t)(kg * 8) * HV + 4 * vq;
#pragma unroll
    for (int i = 0; i < 8; ++i) *(f32x4*)(sout + i * HV) = (f32x4){S[i][0], S[i][1], S[i][2], S[i][3]};
}
__device__ __forceinline__ void p4_scan(const Args& A, LAS unsigned char* lds, int G) {
    constexpr int N_SSD_P = NBP * SH, N_GLA_P = NBP * HH, N_SSD_S = NBS * SH, N_GLA_S = NBS * HH;
    constexpr int NIT = N_SSD_P + N_GLA_P + N_SSD_S + N_GLA_S;
    for (int it = blockIdx.x; it < NIT; it += G) {
        int r = it;
        if (r < N_SSD_P) { ssd_item(A, lds, r / SH, r % SH); continue; } r -= N_SSD_P;
        if (r < N_GLA_P) { gla_item(A, lds, r / HH, r % HH); continue; } r -= N_GLA_P;
        if (r < N_SSD_S) { ssd_item(A, lds, NBP + r / SH, r % SH); continue; } r -= N_SSD_S;
        gla_item(A, lds, NBP + r / HH, r % HH);
    }
}
__device__ __forceinline__ void p5_norm(const Args& A, int vcu, int G) {
    const int tid = tid_op(), lane = tid & 63, wave = __builtin_amdgcn_readfirstlane(tid >> 6), gw = vcu * NWAVES + wave, NGW = G * NWAVES;
    unsigned char* ws = A.ws; bf16* MIX = (bf16*)(ws + WS_MIX); const bf16* OGS = (const bf16*)(ws + WS_OGS); const float* stats = (const float*)(ws + WS_STATS);
    for (int m = gw; m < MT; m += NGW) {
#pragma unroll
        for (int j = 0; j < 4; ++j) {
            const int c = (j * 64 + lane) * 8;
            v4u w = *(const GAS v4u*)(MIX + (size_t)m * 2048 + c);
            float f[8]; f[0] = bf2f((bf16)(w.x & 0xffff)); f[1] = bf2f((bf16)(w.x >> 16)); f[2] = bf2f((bf16)(w.y & 0xffff)); f[3] = bf2f((bf16)(w.y >> 16));
            f[4] = bf2f((bf16)(w.z & 0xffff)); f[5] = bf2f((bf16)(w.z >> 16)); f[6] = bf2f((bf16)(w.w & 0xffff)); f[7] = bf2f((bf16)(w.w >> 16));
            if (c < 1024) { const float r = rsqrtf(stats[ST_SSD + (size_t)m * 2 + (c >> 9)] * (1.0f / 512.0f) + EPS);
#pragma unroll
                for (int i = 0; i < 8; ++i) f[i] *= r;
            } else { const float r = rsqrtf(stats[ST_SHG + (size_t)m * 8 + ((c - 1024) >> 7)] * (1.0f / 128.0f) + EPS);
                const v4u gq = *(const GAS v4u*)(OGS + (size_t)m * DM + (c - 1024));
                float gv[8]; gv[0] = bf2f((bf16)(gq.x & 0xffff)); gv[1] = bf2f((bf16)(gq.x >> 16)); gv[2] = bf2f((bf16)(gq.y & 0xffff)); gv[3] = bf2f((bf16)(gq.y >> 16));
                gv[4] = bf2f((bf16)(gq.z & 0xffff)); gv[5] = bf2f((bf16)(gq.z >> 16)); gv[6] = bf2f((bf16)(gq.w & 0xffff)); gv[7] = bf2f((bf16)(gq.w >> 16));
#pragma unroll
                for (int i = 0; i < 8; ++i) f[i] *= r * gv[i];
            }
            v4u o; o.x = pk2(f[0], f[1]); o.y = pk2(f[2], f[3]); o.z = pk2(f[4], f[5]); o.w = pk2(f[6], f[7]);
            *(GAS v4u*)(MIX + (size_t)m * 2048 + c) = o;
        }
    }
}
__device__ __forceinline__ void p11_final(const Args& A, int vcu, int G) {
    const int tid = tid_op(), lane = tid & 63, wave = __builtin_amdgcn_readfirstlane(tid >> 6), gw = vcu * NWAVES + wave, NGW = G * NWAVES;
    const float* stats = (const float*)(A.ws + WS_STATS); const float* nf = A.in[28];
    for (int m = gw; m < MT; m += NGW) {
        const float r = rsqrtf(stats[ST_SS4 + m] * (1.0f / DM) + EPS);
        GAS f32x4* yr = (GAS f32x4*)(A.out + O_Y + (size_t)m * DM) + lane;
#pragma unroll
        for (int j = 0; j < 4; ++j) { const f32x4 w = ((const GAS f32x4*)nf)[lane + 64 * j]; f32x4 v = yr[64 * j]; v = v * r * w; yr[64 * j] = v; }
    }
}

#ifndef MK_N_LAUNCHES
#define MK_N_LAUNCHES 1
#endif
constexpr int N_PHASES = 12;
__global__ void __launch_bounds__(NTHR, 2) mega(Args A) {
    extern __shared__ __attribute__((aligned(16))) unsigned char lds_raw[];
    LAS unsigned char* lds = (LAS unsigned char*)lds_raw;
    const int G = gridDim.x, bx = blockIdx.x;
    const int vcu = (G % 8 == 0) ? (bx % 8) * (G / 8) + bx / 8 : bx;
    unsigned char* ws = A.ws;
    float* stats = (float*)(ws + WS_STATS);
    bf16* XB = (bf16*)(ws + WS_XB); bf16* ACT = (bf16*)(ws + WS_ACT); float* XR = (float*)(ws + WS_XR);
    const int lo = A.ph_lo, hi = A.ph_hi;
    for (int u = threadIdx.x; u < (LDS_BYTES - LDSCTL_OFF) / 4; u += NTHR) ((LAS unsigned*)(lds + LDSCTL_OFF))[u] = 0u;
    __syncthreads();
    if (hi - lo > 1) (void)xcd_barrier_post((unsigned*)(A.ws + WS_CTL) + CW_BAR, (volatile LAS unsigned*)(lds + MISC_OFF) + 8);
#define IN(k) (A.ph_lo <= (k) && (k) < A.ph_hi)
#define SEAM(k) do { if (IN(k) && IN((k) + 1)) { XcdBarrier b_; b_.bar = (unsigned*)(A.ws + WS_CTL) + CW_BAR; b_.x = xb_xcc_id(); b_.st = (volatile LAS unsigned*)(lds + MISC_OFF) + 8; xcd_barrier(b_); } } while (0)
    if (IN(0)) p0_prologue(A, lds, vcu, G);
    SEAM(0);
    if (IN(1)) { pg8::Gemm g{XB, (const bf16*)(ws + WS_W1U), MT, 2 * DFF, DM}; pg8::StaticOrder S; S.init(MT, 2 * DFF, G, bx);
        pg8::EpiUp E{ACT, stats + ST_SS0}; pg8::gemm_phase<pg8::EpiUp, pg8::StaticOrder, true, true>(lds, g, S, E); }
    SEAM(1);
    if (IN(2)) { pg8::Gemm g{ACT, (const bf16*)(ws + WS_W1D), MT, DM, DFF}; pg8::StaticOrder S; S.init(MT, DM, G, bx);
        pg8::EpiRes E{A.in[0], A.in[1], XR, XB, stats + ST_SS1, 0.5f}; pg8::gemm_phase<pg8::EpiRes, pg8::StaticOrder, true, true>(lds, g, S, E); }
    SEAM(2);
    if (IN(3)) { pg8::Gemm g{XB, (const bf16*)(ws + WS_WIN), MT, DINP, DM}; pg8::StaticOrder S; S.init(MT, DINP, G, bx);
        pg8::EpiIn E{stats + ST_SS1, (bf16*)(ws + WS_ZS), (bf16*)(ws + WS_XBC), (float*)(ws + WS_DT), (bf16*)(ws + WS_QS), (float*)(ws + WS_LOGF), (bf16*)(ws + WS_KK), (bf16*)(ws + WS_VV), (bf16*)(ws + WS_OGS),
                     stats + ST_LB, A.in[14], A.out + O_CP, A.out + O_CS};
        pg8::gemm_phase<pg8::EpiIn, pg8::StaticOrder, true, true>(lds, g, S, E); }
    SEAM(3);
    if (IN(4)) p4_scan(A, lds, G);
    SEAM(4);
    if (IN(5)) p5_norm(A, vcu, G);
    SEAM(5);
    if (IN(6)) { pg8::Gemm g{(const bf16*)(ws + WS_MIX), (const bf16*)(ws + WS_WOUT), MT, DM, 2048}; pg8::StaticOrder S; S.init(MT, DM, G, bx);
        pg8::EpiRes E{XR, XR + (size_t)MP * DM, XR, XB, stats + ST_SS2, 1.0f}; pg8::gemm_phase<pg8::EpiRes, pg8::StaticOrder, true, true>(lds, g, S, E); }
    SEAM(6);
    if (IN(7)) { pg8::Gemm g{XB, (const bf16*)(ws + WS_W2U), MT, 2 * DFF, DM}; pg8::StaticOrder S; S.init(MT, 2 * DFF, G, bx);
        pg8::EpiUp E{ACT, stats + ST_SS2}; pg8::gemm_phase<pg8::EpiUp, pg8::StaticOrder, true, true>(lds, g, S, E); }
    SEAM(7);
    if (IN(8)) { pg8::Gemm g{ACT, (const bf16*)(ws + WS_W2D), MT, DM, DFF}; pg8::StaticOrder S; S.init(MT, DM, G, bx);
        pg8::EpiRes E{XR, XR + (size_t)MP * DM, XR, XB, stats + ST_SS3, 0.5f}; pg8::gemm_phase<pg8::EpiRes, pg8::StaticOrder, true, true>(lds, g, S, E); }
    SEAM(8);
    if (IN(9)) { pg8::Gemm g{(const bf16*)(ws + WS_PB), (const bf16*)(ws + WS_WP), MT, DM, PLE}; pg8::StaticOrder S; S.init(MT, DM, G, bx);
        pg8::EpiE E{(float*)(ws + WS_E), stats + ST_SSE}; pg8::gemm_phase<pg8::EpiE, pg8::StaticOrder, true, true>(lds, g, S, E); }
    SEAM(9);
    if (IN(10)) { pg8::Gemm g{XB, (const bf16*)(ws + WS_WG), MT, DM, DM}; pg8::StaticOrder S; S.init(MT, DM, G, bx);
        pg8::EpiGate E{stats + ST_SS3, (const float*)(ws + WS_E), stats + ST_SSE, A.in[27], XR, A.out + O_Y, stats + ST_SS4};
        pg8::gemm_phase<pg8::EpiGate, pg8::StaticOrder, true, true>(lds, g, S, E); }
    SEAM(10);
    if (IN(11)) p11_final(A, vcu, G);
#undef IN
#undef SEAM
}

extern "C" void kernel_launch(void* const* d_in, const int* in_sizes, int n_in, void* d_out, int out_size, void* d_ws, size_t ws_size, hipStream_t stream) {
    static int grid = 0;
    if (grid == 0) {
        if (n_in != 29 || out_size != (int)O_END || ws_size < WS_END) { fprintf(stderr, "kernel_launch: unexpected problem (n_in %d, out %d, ws %zu)\n", n_in, out_size, ws_size); grid = -1; return; }
        int dev = 0, cus = 0;
        if (hipGetDevice(&dev) != hipSuccess || hipDeviceGetAttribute(&cus, hipDeviceAttributeMultiprocessorCount, dev) != hipSuccess) { grid = -1; return; }
        if (hipFuncSetAttribute((const void*)mega, hipFuncAttributeMaxDynamicSharedMemorySize, LDS_BYTES) != hipSuccess) { fprintf(stderr, "kernel_launch: hipFuncSetAttribute failed\n"); grid = -1; return; }
        int per_cu = 0;
        if (hipOccupancyMaxActiveBlocksPerMultiprocessor(&per_cu, (const void*)mega, NTHR, LDS_BYTES) != hipSuccess || per_cu < 1) { fprintf(stderr, "kernel_launch: occupancy query says %d blocks per CU\n", per_cu); grid = -1; return; }
        (void)hipGetLastError();
        grid = cus;
    }
    if (grid < 0) return;
    Args a{};
    for (int i = 0; i < 29; ++i) a.in[i] = (const float*)d_in[i];
    a.out = (float*)d_out; a.ws = (unsigned char*)d_ws;
#if MK_N_LAUNCHES == 1
    if (hipMemsetAsync((char*)d_ws + WS_CTL, 0, CTL_ZERO_BYTES, stream) != hipSuccess) { fprintf(stderr, "kernel_launch: hipMemsetAsync failed\n"); return; }
    a.ph_lo = 0; a.ph_hi = N_PHASES;
    hipLaunchKernelGGL(mega, dim3(grid), dim3(NTHR), LDS_BYTES, stream, a);
#else
    for (int ph = 0; ph < N_PHASES; ++ph) {
        a.ph_lo = ph; a.ph_hi = ph + 1;
        hipLaunchKernelGGL(mega, dim3(grid), dim3(NTHR), LDS_BYTES, stream, a);
    }
#endif
}
```

```cpp
#include <hip/hip_runtime.h>
#include <hip/hip_cooperative_groups.h>
#include <cstdio>
#include <cstdint>
namespace pg8 {
#define PG8_LAS __attribute__((address_space(3)))
typedef unsigned short bf16_t;
typedef short bf16x8 __attribute__((ext_vector_type(8)));
typedef float f32x4 __attribute__((ext_vector_type(4)));
typedef unsigned u32x4 __attribute__((ext_vector_type(4)));
constexpr int BM = 256, BK = 64, HALF = 128, HTB = HALF * BK * 2  , STAGE_BYTES = 8 * HTB, NXCD = 8, WGM = 8;

__host__ __device__ __forceinline__ int lds_byte(int r, int c) { const int st = (r >> 4) * 2 + (c >> 5), rr = r & 15, cc = c & 31, ob = rr * 64 + cc * 2; return st * 1024 + (ob ^ (((ob >> 9) & 1) << 5)); }
__host__ __device__ __forceinline__ void stage_rc(int b, int& R, int& C) { const int st = b / 1024, sb = b % 1024, swz = sb ^ (((sb >> 9) & 1) << 5); R = (st >> 1) * 16 + swz / 64; C = (st & 1) * 32 + (swz % 64) / 2; }
__host__ __device__ __forceinline__ int perm32(int rho) { const int n = rho >> 4, i = rho & 15; return 8 * (i >> 2) + 4 * n + (i & 3); }

struct Unit { int pm, pn; };
struct Gemm { const bf16_t* A; const bf16_t* Bt; int M, N, K; };

struct StaticOrder {
    int nM, nN, nwg, G, c;
    __host__ __device__ void init(int M, int N, int G_, int c_) { nM = M / BM; nN = N / BM; nwg = nM * nN; G = G_; c = c_; }
    __host__ __device__ bool next(int i, Unit& u) const {
        const long L = (long)i * G + c; if (L >= nwg) return false;
        int wgid = (int)L; { const int q = nwg / NXCD, r = nwg % NXCD, xcd = wgid % NXCD, off = wgid / NXCD; wgid = (xcd < r ? xcd * (q + 1) : r * (q + 1) + (xcd - r) * q) + off; }
        const int nig = WGM * nN, gid = wgid / nig, fm = gid * WGM, gsz = (nM - fm) < WGM ? (nM - fm) : WGM;
        u.pm = fm + ((wgid % nig) % gsz); u.pn = (wgid % nig) / gsz; return true;
    }
    __device__ __forceinline__ void a_ready(const Unit&) const {}
    __device__ __forceinline__ void done(const Unit&) const {}
};
__device__ __forceinline__ unsigned cvt_pk_bf16(float lo, float hi) { unsigned r; asm volatile("v_cvt_pk_bf16_f32 %0, %1, %2" : "=v"(r) : "v"(lo), "v"(hi)); return r; }
typedef float f32x2 __attribute__((ext_vector_type(2)));
template <class Epi, class Sched, bool ALIGN_EPI = false, bool SP2 = false>
__device__ __forceinline__ void gemm_phase(PG8_LAS unsigned char* lds, const Gemm g, const Sched& S, const Epi& E) {
    const int tid = threadIdx.x, wid = __builtin_amdgcn_readfirstlane(tid >> 6), lane = tid & 63, wr = wid >> 2, wc = wid & 3, fr = lane & 15, fq = lane >> 4;
    const int K = g.K, nt = K / BK;
    unsigned voffA[2], voffB[2];
#pragma unroll
    for (int i = 0; i < 2; ++i) { int R, C; stage_rc(tid * 16 + i * 8192, R, C); const int Rb = Epi::PERM ? ((R & ~31) + perm32(R & 31)) : R;
        voffA[i] = (unsigned)(R * K + C) * 2u; voffB[i] = (unsigned)(Rb * K + C) * 2u; }
    const size_t kstep = (size_t)(BK * 2);
    const size_t hstep = (size_t)HALF * K * 2;
    const size_t tstep = 2 * hstep;
    const unsigned ldsw = (unsigned)wid * 1024u;
    const int aoff = lds_byte(wr * 64 + fr, fq * 8), boff = lds_byte(wc * 32 + fr, fq * 8);
#define PG8_SA(b, h) (((b) * 2 + (h)) * HTB)
#define PG8_SB(b, h) ((4 + (b) * 2 + (h)) * HTB)
#define PG8_STAGE(bufoff, gbase, voff) do { _Pragma("unroll") for (int _i = 0; _i < 2; ++_i) \
        __builtin_amdgcn_global_load_lds((const unsigned*)((const char*)(gbase) + (voff)[_i]), (PG8_LAS unsigned*)(lds + (bufoff) + ldsw + _i * 8192), 16, 0, 0); } while (0)
#define PG8_LDA(dst, b, h) do { _Pragma("unroll") for (int m = 0; m < 4; ++m) _Pragma("unroll") for (int k = 0; k < 2; ++k) dst[m][k] = *(const PG8_LAS bf16x8*)(lds + PG8_SA(b, h) + aoff + m * 2048 + k * 1024); } while (0)
#define PG8_LDB(dst, b, h) do { _Pragma("unroll") for (int n = 0; n < 2; ++n) _Pragma("unroll") for (int k = 0; k < 2; ++k) dst[n][k] = *(const PG8_LAS bf16x8*)(lds + PG8_SB(b, h) + boff + n * 2048 + k * 1024); } while (0)
#define PG8_MMA(ai, bj, At, Bt) do { __builtin_amdgcn_s_setprio(1); _Pragma("unroll") for (int m = 0; m < 4; ++m) _Pragma("unroll") for (int n = 0; n < 2; ++n) _Pragma("unroll") for (int k = 0; k < 2; ++k) \
        acc[ai][bj][m][n] = __builtin_amdgcn_mfma_f32_16x16x32_bf16(Bt[n][k], At[m][k], acc[ai][bj][m][n], 0, 0, 0); __builtin_amdgcn_s_setprio(0); } while (0)
#define PG8_WAIT_V(n) asm volatile("s_waitcnt vmcnt(" #n ")" ::: "memory")
#define PG8_WAIT_L(n) asm volatile("s_waitcnt lgkmcnt(" #n ")" ::: "memory")
#define PG8_BAR __builtin_amdgcn_s_barrier()
#define PG8_SCHED __builtin_amdgcn_sched_barrier(0)
    Unit cur, nxt; int ui = 0;
    if (!S.next(0, cur)) return;
    f32x4 acc[2][2][4][2];
#pragma unroll
    for (int a = 0; a < 2; ++a)
#pragma unroll
        for (int b = 0; b < 2; ++b)
#pragma unroll
            for (int m = 0; m < 4; ++m)
#pragma unroll
                for (int n = 0; n < 2; ++n) acc[a][b][m][n] = (f32x4){0.f, 0.f, 0.f, 0.f};
    bf16x8 At[4][2], B0[2][2], B1[2][2];
    const char* cA = (const char*)g.A + (size_t)cur.pm * tstep; const char* cB = (const char*)g.Bt + (size_t)cur.pn * tstep;
    S.a_ready(cur);
    if constexpr (SP2) {
        PG8_STAGE(PG8_SB(0, 0), cB, voffB); PG8_STAGE(PG8_SB(0, 1), cB + hstep, voffB); PG8_STAGE(PG8_SA(0, 0), cA, voffA); PG8_STAGE(PG8_SA(0, 1), cA + hstep, voffA);
        if (wr == 1) PG8_BAR;
        PG8_WAIT_V(2); PG8_BAR;
        PG8_STAGE(PG8_SB(1, 0), cB + kstep, voffB); PG8_STAGE(PG8_SA(1, 0), cA + kstep, voffA); PG8_STAGE(PG8_SB(1, 1), cB + hstep + kstep, voffB);
        PG8_WAIT_V(6); PG8_BAR;
    } else {
        PG8_STAGE(PG8_SB(0, 0), cB, voffB); PG8_STAGE(PG8_SA(0, 0), cA, voffA); PG8_STAGE(PG8_SB(0, 1), cB + hstep, voffB); PG8_STAGE(PG8_SA(0, 1), cA + hstep, voffA);
        if (wr == 1) PG8_BAR;
        PG8_WAIT_V(4); PG8_BAR;
        PG8_STAGE(PG8_SB(1, 0), cB + kstep, voffB); PG8_STAGE(PG8_SA(1, 0), cA + kstep, voffA); PG8_STAGE(PG8_SB(1, 1), cB + hstep + kstep, voffB);
        PG8_WAIT_V(6); PG8_BAR;
    }
    for (;;) {
        const bool has_next = S.next(ui + 1, nxt);
        const char* nA = has_next ? (const char*)g.A + (size_t)nxt.pm * tstep : cA; const char* nB = has_next ? (const char*)g.Bt + (size_t)nxt.pn * tstep : cB;
        for (int t = 0; t < nt; t += 2) {
            const bool last = (t == nt - 2);
            const char* a1 = cA + (size_t)(t + 1) * kstep;
            const char* a2 = last ? nA : cA + (size_t)(t + 2) * kstep; const char* b2 = last ? nB : cB + (size_t)(t + 2) * kstep;
            const char* a3 = a2 + kstep; const char* b3 = b2 + kstep;
            if (last && has_next) S.a_ready(nxt);
            if constexpr (SP2) {
            PG8_LDB(B0, 0, 0); PG8_LDB(B1, 0, 1); PG8_SCHED; PG8_LDA(At, 0, 0); PG8_STAGE(PG8_SA(1, 1), a1 + hstep, voffA);
            PG8_WAIT_V(8); PG8_WAIT_L(0); PG8_BAR; PG8_MMA(0, 0, At, B0); PG8_MMA(0, 1, At, B1); PG8_BAR; PG8_SCHED;
            PG8_LDA(At, 0, 1); PG8_STAGE(PG8_SB(0, 0), b2, voffB); PG8_STAGE(PG8_SB(0, 1), b2 + hstep, voffB); PG8_STAGE(PG8_SA(0, 0), a2, voffA);
            PG8_WAIT_V(8); PG8_WAIT_L(0); PG8_BAR; PG8_MMA(1, 0, At, B0); PG8_MMA(1, 1, At, B1); PG8_BAR; PG8_SCHED;
            PG8_LDB(B0, 1, 0); PG8_LDB(B1, 1, 1); PG8_SCHED; PG8_LDA(At, 1, 0); PG8_STAGE(PG8_SA(0, 1), a2 + hstep, voffA);
            PG8_WAIT_V(8); PG8_WAIT_L(0); PG8_BAR; PG8_MMA(0, 0, At, B0); PG8_MMA(0, 1, At, B1); PG8_BAR; PG8_SCHED;
            PG8_LDA(At, 1, 1); PG8_STAGE(PG8_SB(1, 0), b3, voffB); PG8_STAGE(PG8_SB(1, 1), b3 + hstep, voffB); PG8_STAGE(PG8_SA(1, 0), a3, voffA);
            PG8_WAIT_V(8); PG8_WAIT_L(0); PG8_BAR; PG8_MMA(1, 0, At, B0); PG8_MMA(1, 1, At, B1); PG8_BAR; PG8_SCHED;
            } else {
            PG8_LDB(B0, 0, 0); PG8_SCHED; PG8_LDA(At, 0, 0); PG8_STAGE(PG8_SA(1, 1), a1 + hstep, voffA);
            PG8_WAIT_L(8); PG8_BAR; PG8_WAIT_L(0); PG8_MMA(0, 0, At, B0); PG8_BAR; PG8_SCHED;
            PG8_LDB(B1, 0, 1); PG8_STAGE(PG8_SB(0, 0), b2, voffB);
            PG8_BAR; PG8_WAIT_L(0); PG8_MMA(0, 1, At, B1); PG8_BAR;
            PG8_LDA(At, 0, 1); PG8_STAGE(PG8_SA(0, 0), a2, voffA);
            PG8_BAR; PG8_WAIT_L(0); PG8_MMA(1, 0, At, B0); PG8_BAR; PG8_SCHED;
            PG8_STAGE(PG8_SB(0, 1), b2 + hstep, voffB);
            PG8_WAIT_V(6); PG8_BAR; PG8_MMA(1, 1, At, B1); PG8_BAR;
            PG8_LDB(B0, 1, 0); PG8_SCHED; PG8_LDA(At, 1, 0); PG8_STAGE(PG8_SA(0, 1), a2 + hstep, voffA);
            PG8_WAIT_L(8); PG8_BAR; PG8_WAIT_L(0); PG8_MMA(0, 0, At, B0); PG8_BAR; PG8_SCHED;
            PG8_LDB(B1, 1, 1); PG8_STAGE(PG8_SB(1, 0), b3, voffB);
            PG8_BAR; PG8_WAIT_L(0); PG8_MMA(0, 1, At, B1); PG8_BAR;
            PG8_LDA(At, 1, 1); PG8_STAGE(PG8_SA(1, 0), a3, voffA);
            PG8_BAR; PG8_WAIT_L(0); PG8_MMA(1, 0, At, B0); PG8_BAR; PG8_SCHED;
            PG8_STAGE(PG8_SB(1, 1), b3 + hstep, voffB);
            PG8_WAIT_V(6); PG8_BAR; PG8_MMA(1, 1, At, B1); PG8_BAR;
            }
        }
        if constexpr (ALIGN_EPI) { if (wr == 0) PG8_BAR; }
        if constexpr (!Epi::AFTER_DRAIN) { E(acc, cur, wr, wc, fr, fq); S.done(cur); }
        if (!has_next) break;
#pragma unroll
        for (int a = 0; a < 2; ++a)
#pragma unroll
            for (int b = 0; b < 2; ++b)
#pragma unroll
                for (int m = 0; m < 4; ++m)
#pragma unroll
                    for (int n = 0; n < 2; ++n) acc[a][b][m][n] = (f32x4){0.f, 0.f, 0.f, 0.f};
        cur = nxt; cA = nA; cB = nB; ++ui;
        if constexpr (ALIGN_EPI) { if (wr == 1) PG8_BAR; }
    }
    PG8_WAIT_V(0);
    if constexpr (!ALIGN_EPI) { if (wr == 0) PG8_BAR; }
    PG8_BAR;
    if constexpr (Epi::AFTER_DRAIN) { E.fused(acc, cur, wr, wc, fr, fq, lds, wid, lane); S.done(cur); }
#undef PG8_SA
#undef PG8_SB
#undef PG8_STAGE
#undef PG8_LDA
#undef PG8_LDB
#undef PG8_MMA
#undef PG8_WAIT_V
#undef PG8_WAIT_L
#undef PG8_BAR
#undef PG8_SCHED
}
}
#define GAS __attribute__((address_space(1)))
#define LAS __attribute__((address_space(3)))
typedef unsigned short bf16;
typedef unsigned v4u __attribute__((ext_vector_type(4)));
typedef float f32x4 __attribute__((ext_vector_type(4)));
typedef short bf16x8 __attribute__((ext_vector_type(8)));
typedef GAS unsigned gu32;
typedef GAS unsigned long long gu64;
#define RLX_AGENT __ATOMIC_RELAXED, __HIP_MEMORY_SCOPE_AGENT
#define LDS_WAIT() asm volatile("s_waitcnt lgkmcnt(0)" ::: "memory")
#define VM_WAIT() asm volatile("s_waitcnt vmcnt(0)" ::: "memory")
__device__ __forceinline__ unsigned long long rt() { return __builtin_amdgcn_s_memrealtime(); }
__device__ __forceinline__ unsigned f2bf(float f) { unsigned u = __builtin_bit_cast(unsigned, f); return (u + 0x7fffu + ((u >> 16) & 1u)) >> 16; }
__device__ __forceinline__ unsigned pk2(float lo, float hi) { return f2bf(lo) | (f2bf(hi) << 16); }
#define XB_TMO      128
#define XB_XCNT(j)  (256  + 64 * (j))
#define XB_XSUB(j)  (1280 + 64 * (j))
#define XB_XGEN(j)  (2304 + 64 * (j))
#define XB_TOP      3328
#define XB_TOPGEN   3392
#define XCD_BAR_WORDS 3456
#define XB_SPIN_CAP (1u << 18)

__device__ __forceinline__ unsigned xb_ld(unsigned* p)              { return __hip_atomic_load(p, __ATOMIC_RELAXED, __HIP_MEMORY_SCOPE_AGENT); }
__device__ __forceinline__ unsigned xb_add(unsigned* p, unsigned v) { return __hip_atomic_fetch_add(p, v, __ATOMIC_RELAXED, __HIP_MEMORY_SCOPE_AGENT); }
__device__ __forceinline__ unsigned xb_xcc_id() { return (unsigned)__builtin_amdgcn_s_getreg((3 << 11) | 20) & 0xFu; }
#define XB_SPIN(cond, bar) do { unsigned _sp = 0; while (cond) { __builtin_amdgcn_s_sleep(1); \
    if ((++_sp & 255u) == 0u) { if (xb_ld(&(bar)[XB_TMO])) break; if (_sp > XB_SPIN_CAP) { atomicAdd(&(bar)[XB_TMO], 1u); break; } } } } while (0)

struct XcdBarrier {
    unsigned* bar; unsigned x;
    volatile LAS unsigned* st;
};

__device__ __forceinline__ XcdBarrier xcd_barrier_post(unsigned* bar, volatile LAS unsigned* st) {
    XcdBarrier b; b.bar = bar; b.x = xb_xcc_id(); b.st = st;
    if (threadIdx.x == 0) (void)xb_add(&bar[XB_XCNT(b.x)], 1u);
    return b;
}
__device__ __forceinline__ void xcd_barrier_complete(unsigned* bar, unsigned x, unsigned& nloc, unsigned& nx) {
    const unsigned G = gridDim.x * gridDim.y * gridDim.z;
    unsigned sum, cnt, mine, sp = 0u;
    for (;;) {
        sum = 0u; cnt = 0u; mine = 0u;
#pragma unroll
        for (unsigned j = 0; j < 16; ++j) { const unsigned c = xb_ld(&bar[XB_XCNT(j)]); sum += c; cnt += (c > 0u) ? 1u : 0u; mine = (j == x) ? c : mine; }
        if (sum == G) break;
        __builtin_amdgcn_s_sleep(1);
        if ((++sp & 255u) == 0u) { if (xb_ld(&bar[XB_TMO])) break; if (sp > XB_SPIN_CAP) { atomicAdd(&bar[XB_TMO], 1u); break; } }
    }
    nloc = mine > 0u ? mine : 1u; nx = cnt > 0u ? cnt : 1u;
}

__device__ __forceinline__ void xcd_barrier(const XcdBarrier& b) {
    asm volatile("s_waitcnt vmcnt(0)" ::: "memory");
    __syncthreads();
    if (threadIdx.x == 0) {
        unsigned* bar = b.bar;
        __builtin_amdgcn_s_waitcnt(0);
        unsigned nloc = b.st[0], nx = b.st[1];
        if (nloc == 0u) { xcd_barrier_complete(bar, b.x, nloc, nx); b.st[0] = nloc; b.st[1] = nx; }
        const unsigned old = xb_add(&bar[XB_XSUB(b.x)], 1u);
        const unsigned gen = old / nloc;
        if (old + 1u == (gen + 1u) * nloc) {
            __builtin_amdgcn_fence(__ATOMIC_RELEASE, "agent");
            asm volatile("s_waitcnt vmcnt(0)" ::: "memory");
            const unsigned og = xb_add(&bar[XB_TOP], 1u);
            const unsigned tg = og / nx;
            if (og + 1u == (tg + 1u) * nx) xb_add(&bar[XB_TOPGEN], 1u);
            else XB_SPIN(xb_ld(&bar[XB_TOPGEN]) == tg, bar);
            __builtin_amdgcn_fence(__ATOMIC_ACQUIRE, "agent");
            xb_add(&bar[XB_XGEN(b.x)], 1u);
            asm volatile("s_waitcnt vmcnt(0)" ::: "memory");
        } else {
            XB_SPIN(xb_ld(&bar[XB_XGEN(b.x)]) == gen, bar);
            __builtin_amdgcn_fence(__ATOMIC_ACQUIRE, "agent");
            asm volatile("s_waitcnt vmcnt(0)" ::: "memory");
        }
    }
    __syncthreads();
}

constexpr int DM = 1024, NBP = 8, SEQ = 2048, NBS = 128, DSEQ = 4;
constexpr int MP = NBP * SEQ, MS = NBS * DSEQ, MT = MP + MS;
constexpr int PLE = 256, DFF = 2816;
constexpr int SH = 16, SP = 64, SN = 128, CONVD = 1536;
constexpr int HH = 8, HK = 128, HV = 128;
constexpr int DIN = 6672, DINP = 6912;
constexpr float EPS = 1e-6f;
constexpr int NSEQ = NBP + NBS;
constexpr int NWAVES = 8, NTHR = 512;
constexpr size_t O_Y = 0, O_CP = 17301504, O_SP = 17338368, O_HP = 18386944, O_CS = 19435520, O_SS = 20025344, O_HS = 36802560, O_END = 53579776;
constexpr size_t MiB = 1u << 20;
constexpr size_t WS_CTL = 0, CTL_ZERO_BYTES = 1 * MiB;
constexpr size_t WS_STATS = 1 * MiB;
constexpr size_t WS_W1U = 4 * MiB, WS_W1D = 16 * MiB, WS_WIN = 22 * MiB, WS_WOUT = 36 * MiB, WS_W2U = 40 * MiB, WS_W2D = 52 * MiB, WS_WG = 58 * MiB, WS_WP = 60 * MiB;
constexpr size_t WS_XB = 64 * MiB, WS_PB = 98 * MiB, WS_XR = 108 * MiB, WS_ACT = 176 * MiB;
constexpr size_t WS_ZS = 268 * MiB, WS_XBC = 302 * MiB, WS_DT = 352 * MiB, WS_QS = 354 * MiB, WS_LOGF = 388 * MiB, WS_KK = 454 * MiB, WS_VV = 488 * MiB, WS_OGS = 522 * MiB;
constexpr size_t WS_MIX = 556 * MiB, WS_E = 622 * MiB, WS_CONV = 688 * MiB, WS_END = 738 * MiB;
static_assert(WS_W1U + (size_t)5632 * 1024 * 2 <= WS_W1D && WS_W1D + (size_t)1024 * 2816 * 2 <= WS_WIN && WS_WIN + (size_t)DINP * 1024 * 2 <= WS_WOUT && WS_WOUT + (size_t)1024 * 2048 * 2 <= WS_W2U, "ws map (weights)");
static_assert(WS_XB + (size_t)MT * 1024 * 2 <= WS_PB && WS_PB + (size_t)MT * 256 * 2 <= WS_XR && WS_XR + (size_t)MT * 1024 * 4 <= WS_ACT && WS_ACT + (size_t)MT * DFF * 2 <= WS_ZS, "ws map (acts)");
static_assert(WS_ZS + (size_t)MT * 1024 * 2 <= WS_XBC && WS_XBC + (size_t)MT * 1536 * 2 <= WS_DT && WS_DT + (size_t)MT * 16 * 4 <= WS_QS && WS_QS + (size_t)MT * 1024 * 2 <= WS_LOGF && WS_LOGF + (size_t)MT * 1024 * 4 <= WS_KK, "ws map (proj)");
static_assert(WS_MIX + (size_t)MT * 2048 * 2 <= WS_E && WS_E + (size_t)MT * 1024 * 4 <= WS_CONV && WS_CONV + (size_t)MP * 1536 * 2 <= WS_END, "ws map (mix)");
constexpr int ST_SS0 = 0, ST_SS1 = MT, ST_SS2 = 2 * MT, ST_SS3 = 3 * MT, ST_SS4 = 4 * MT, ST_SSE = 5 * MT, ST_SSD = 6 * MT, ST_SHG = 8 * MT, ST_LB = 16 * MT, ST_END = 16 * MT + 1024;
static_assert((size_t)ST_END * 4 <= 3 * MiB, "stats region");
constexpr int CW_BAR = 4096, CW_Q = 64;
constexpr int RING_BYTES = 131072, LDS_BYTES = 163840, LDSCTL_OFF = LDS_BYTES - 1024, MISC_OFF = LDSCTL_OFF + 320;

__device__ __forceinline__ float bf2f(bf16 b) { return __builtin_bit_cast(float, (unsigned)b << 16); }
__device__ __forceinline__ float siluf(float x) { return x / (1.0f + __expf(-x)); }
__device__ __forceinline__ float sigmoidf_(float x) { return 1.0f / (1.0f + __expf(-x)); }
__device__ __forceinline__ float softplusf_(float x) { return fmaxf(x, 0.f) + log1pf(__expf(-fabsf(x))); }
__device__ __forceinline__ int tid_op() { int t = threadIdx.x; asm volatile("" : "+v"(t)); return t; }
__device__ __forceinline__ float wave_sum(float v) {
#pragma unroll
    for (int o = 1; o < 64; o <<= 1) v += __shfl_xor(v, o);
    return v;
}

constexpr int ST_DTB = ST_LB + 1024, ST_POST = ST_DTB + 16;
static_assert((size_t)(ST_POST + 1024) * 4 <= 3 * MiB, "stats region");
namespace pg8 {
typedef const f32x4 (&AccRef)[2][2][4][2];
__device__ __forceinline__ void epi_up(AccRef acc, const Unit& u, int wr, int wc, int fr, int fq, bf16_t* O, const float* ss) {
    const int row0 = u.pm * BM + wr * 64 + fr, col0 = u.pn * 128 + wc * 32 + 8 * fq;
#pragma unroll
    for (int ai = 0; ai < 2; ++ai)
#pragma unroll
        for (int m = 0; m < 4; ++m) {
            const int row = row0 + ai * HALF + m * 16;
            const float rs = rsqrtf(ss[row] * (1.0f / DM) + EPS);
            float a[8];
#pragma unroll
            for (int n = 0; n < 2; ++n)
#pragma unroll
                for (int i = 0; i < 4; ++i) { const float g = acc[ai][0][m][n][i] * rs, uu = acc[ai][1][m][n][i] * rs; a[4 * n + i] = siluf(g) * uu; }
            u32x4 w; w.x = cvt_pk_bf16(a[0], a[1]); w.y = cvt_pk_bf16(a[2], a[3]); w.z = cvt_pk_bf16(a[4], a[5]); w.w = cvt_pk_bf16(a[6], a[7]);
            *(u32x4*)(O + (size_t)row * DFF + col0) = w;
        }
}
__device__ __forceinline__ void epi_res(AccRef acc, const Unit& u, int wr, int wc, int fr, int fq, const float* resP, const float* resS, float* xr, bf16_t* xb, float* ssout, float alpha) {
    const int row0 = u.pm * BM + wr * 64 + fr, col0 = u.pn * BM + wc * 32 + 8 * fq;
#pragma unroll
    for (int ai = 0; ai < 2; ++ai)
#pragma unroll
        for (int m = 0; m < 4; ++m) {
            const int row = row0 + ai * HALF + m * 16;
            const float* rp = (row < MP) ? resP + (size_t)row * DM : resS + (size_t)(row - MP) * DM;
            float sq = 0.f;
#pragma unroll
            for (int bj = 0; bj < 2; ++bj) {
                const int c = col0 + bj * HALF;
                const f32x4 r0 = *(const f32x4*)(rp + c), r1 = *(const f32x4*)(rp + c + 4);
                const f32x4 v0 = r0 + acc[ai][bj][m][0] * alpha, v1 = r1 + acc[ai][bj][m][1] * alpha;
                *(f32x4*)(xr + (size_t)row * DM + c) = v0; *(f32x4*)(xr + (size_t)row * DM + c + 4) = v1;
                u32x4 w; w.x = cvt_pk_bf16(v0[0], v0[1]); w.y = cvt_pk_bf16(v0[2], v0[3]); w.z = cvt_pk_bf16(v1[0], v1[1]); w.w = cvt_pk_bf16(v1[2], v1[3]);
                *(u32x4*)(xb + (size_t)row * DM + c) = w;
                sq += (v0[0] * v0[0] + v0[1] * v0[1]) + (v0[2] * v0[2] + v0[3] * v0[3]) + (v1[0] * v1[0] + v1[1] * v1[1]) + (v1[2] * v1[2] + v1[3] * v1[3]);
            }
            sq += __shfl_xor(sq, 16); sq += __shfl_xor(sq, 32);
            if (fq == 0) atomicAdd(ssout + row, sq);
        }
}
template <int KIND>
__device__ __forceinline__ void epi_in_kind(AccRef acc, int row0, int cbase, int wc, int fq, const float* ss, bf16_t* ob, int ldo, float* of, const float* aux, float* conv_p, float* conv_s) {
#pragma unroll
    for (int ai = 0; ai < 2; ++ai)
#pragma unroll
        for (int m = 0; m < 4; ++m) {
            const int row = row0 + ai * HALF + m * 16;
            const float rs = rsqrtf(ss[row] * (1.0f / DM) + EPS);
#pragma unroll
            for (int bj = 0; bj < 2; ++bj) {
                float v[8];
#pragma unroll
                for (int n = 0; n < 2; ++n)
#pragma unroll
                    for (int i = 0; i < 4; ++i) v[4 * n + i] = acc[ai][bj][m][n][i] * rs;
                const int ct = bj * HALF + wc * 32 + 8 * fq, c = cbase + ct;
                if (KIND == 0) {
                    u32x4 w; w.x = cvt_pk_bf16(siluf(v[0]), siluf(v[1])); w.y = cvt_pk_bf16(siluf(v[2]), siluf(v[3])); w.z = cvt_pk_bf16(siluf(v[4]), siluf(v[5])); w.w = cvt_pk_bf16(siluf(v[6]), siluf(v[7]));
                    *(u32x4*)(ob + (size_t)row * ldo + c) = w;
                } else if (KIND == 1 || KIND == 2) {
                    u32x4 w; w.x = cvt_pk_bf16(v[0], v[1]); w.y = cvt_pk_bf16(v[2], v[3]); w.z = cvt_pk_bf16(v[4], v[5]); w.w = cvt_pk_bf16(v[6], v[7]);
                    *(u32x4*)(ob + (size_t)row * ldo + c) = w;
                    if (KIND == 2) {
                        float* dst = nullptr;
                        if (row < MP) { const int t = row & (SEQ - 1); if (t >= SEQ - 3) dst = conv_p + ((size_t)(row >> 11) * 3 + (t - (SEQ - 3))) * CONVD + c; }
                        else { const int t = row & 3; if (t >= 1) dst = conv_s + ((size_t)((row - MP) >> 2) * 3 + (t - 1)) * CONVD + c; }
                        if (dst) { *(f32x4*)dst = (f32x4){v[0], v[1], v[2], v[3]}; *(f32x4*)(dst + 4) = (f32x4){v[4], v[5], v[6], v[7]}; }
                    }
                } else if (KIND == 3) {
                    const f32x4 l0 = *(const f32x4*)(aux + c), l1 = *(const f32x4*)(aux + c + 4);
                    float lf[8], kv[8];
#pragma unroll
                    for (int i = 0; i < 8; ++i) { const float lbv = i < 4 ? l0[i & 3] : l1[i & 3]; const float f = lbv + (1.0f - lbv) * sigmoidf_(v[i]); lf[i] = __logf(f); kv[i] = 1.0f - f; }
                    *(f32x4*)(of + (size_t)row * DM + c) = (f32x4){lf[0], lf[1], lf[2], lf[3]}; *(f32x4*)(of + (size_t)row * DM + c + 4) = (f32x4){lf[4], lf[5], lf[6], lf[7]};
                    u32x4 w; w.x = cvt_pk_bf16(kv[0], kv[1]); w.y = cvt_pk_bf16(kv[2], kv[3]); w.z = cvt_pk_bf16(kv[4], kv[5]); w.w = cvt_pk_bf16(kv[6], kv[7]);
                    *(u32x4*)(ob + (size_t)row * ldo + c) = w;
                } else {
                    if (ct < 16) {
                        const f32x4 b0 = *(const f32x4*)(aux + ct), b1 = *(const f32x4*)(aux + ct + 4);
                        f32x4 o0, o1;
#pragma unroll
                        for (int i = 0; i < 4; ++i) { o0[i] = softplusf_(v[i] + b0[i]); o1[i] = softplusf_(v[4 + i] + b1[i]); }
                        *(f32x4*)(of + (size_t)row * 16 + ct) = o0; *(f32x4*)(of + (size_t)row * 16 + ct + 4) = o1;
                    }
                }
            }
        }
}
__device__ __forceinline__ void epi_e(AccRef acc, const Unit& u, int wr, int wc, int fr, int fq, float* E, float* sse) {
    const int row0 = u.pm * BM + wr * 64 + fr, col0 = u.pn * BM + wc * 32 + 8 * fq;
#pragma unroll
    for (int ai = 0; ai < 2; ++ai)
#pragma unroll
        for (int m = 0; m < 4; ++m) {
            const int row = row0 + ai * HALF + m * 16; float sq = 0.f;
#pragma unroll
            for (int bj = 0; bj < 2; ++bj) {
                const int c = col0 + bj * HALF; const f32x4 v0 = acc[ai][bj][m][0], v1 = acc[ai][bj][m][1];
                *(f32x4*)(E + (size_t)row * DM + c) = v0; *(f32x4*)(E + (size_t)row * DM + c + 4) = v1;
                sq += (v0[0] * v0[0] + v0[1] * v0[1]) + (v0[2] * v0[2] + v0[3] * v0[3]) + (v1[0] * v1[0] + v1[1] * v1[1]) + (v1[2] * v1[2] + v1[3] * v1[3]);
            }
            sq += __shfl_xor(sq, 16); sq += __shfl_xor(sq, 32);
            if (fq == 0) atomicAdd(sse + row, sq);
        }
}
__device__ __forceinline__ void epi_gate(AccRef acc, const Unit& u, int wr, int wc, int fr, int fq, const float* ss3, const float* E, const float* sse, const float* post, const float* xr, float* y, float* ss4) {
    const int row0 = u.pm * BM + wr * 64 + fr, col0 = u.pn * BM + wc * 32 + 8 * fq;
#pragma unroll
    for (int ai = 0; ai < 2; ++ai)
#pragma unroll
        for (int m = 0; m < 4; ++m) {
            const int row = row0 + ai * HALF + m * 16; float sq = 0.f;
            const float rs = rsqrtf(ss3[row] * (1.0f / DM) + EPS), re = rsqrtf(sse[row] * (1.0f / DM) + EPS);
#pragma unroll
            for (int bj = 0; bj < 2; ++bj) {
                const int c = col0 + bj * HALF;
#pragma unroll
                for (int n = 0; n < 2; ++n) {
                    const f32x4 e = *(const f32x4*)(E + (size_t)row * DM + c + 4 * n), pw = *(const f32x4*)(post + c + 4 * n), x = *(const f32x4*)(xr + (size_t)row * DM + c + 4 * n);
                    f32x4 o;
#pragma unroll
                    for (int i = 0; i < 4; ++i) { o[i] = x[i] + sigmoidf_(acc[ai][bj][m][n][i] * rs) * (e[i] * re * pw[i]); sq += o[i] * o[i]; }
                    *(f32x4*)(y + (size_t)row * DM + c + 4 * n) = o;
                }
            }
            sq += __shfl_xor(sq, 16); sq += __shfl_xor(sq, 32);
            if (fq == 0) atomicAdd(ss4 + row, sq);
        }
}
constexpr int PH_UP1 = 1, PH_DN1 = 2, PH_IN = 3, PH_OUT = 7, PH_UP2 = 8, PH_DN2 = 9, PH_PLE = 10, PH_GATE = 11;
struct EpiAny {
    static constexpr bool PERM = true, AFTER_DRAIN = false;
    unsigned char* ws; float* out; const float* xP; const float* xS; int ph;
    __device__ __forceinline__ void operator()(AccRef acc, const Unit& u, int wr, int wc, int fr_, int fq_) const {
        int lane_ = threadIdx.x & 63; asm volatile("" : "+v"(lane_)); const int fr = lane_ & 15, fq = lane_ >> 4;
        unsigned char* w_ = ws; asm volatile("" : "+s"(w_));
        float* stats = (float*)(w_ + WS_STATS); float* XR = (float*)(w_ + WS_XR); bf16_t* XB = (bf16_t*)(w_ + WS_XB); bf16_t* ACT = (bf16_t*)(w_ + WS_ACT);
        if (ph == PH_UP1 || ph == PH_UP2) epi_up(acc, u, wr, wc, fr, fq, ACT, stats + (ph == PH_UP1 ? ST_SS0 : ST_SS2));
        else if (ph == PH_DN1) epi_res(acc, u, wr, wc, fr, fq, xP, xS, XR, XB, stats + ST_SS1, 0.5f);
        else if (ph == PH_OUT) epi_res(acc, u, wr, wc, fr, fq, XR, XR + (size_t)MP * DM, XR, XB, stats + ST_SS2, 1.0f);
        else if (ph == PH_DN2) epi_res(acc, u, wr, wc, fr, fq, XR, XR + (size_t)MP * DM, XR, XB, stats + ST_SS3, 0.5f);
        else if (ph == PH_IN) {
            const int row0 = u.pm * BM + wr * 64 + fr, pn = u.pn; const float* ss = stats + ST_SS1;
            if (pn < 4) epi_in_kind<0>(acc, row0, pn * 256, wc, fq, ss, (bf16_t*)(w_ + WS_ZS), DM, nullptr, nullptr, nullptr, nullptr);
            else if (pn < 10) epi_in_kind<2>(acc, row0, (pn - 4) * 256, wc, fq, ss, (bf16_t*)(w_ + WS_XBC), CONVD, nullptr, nullptr, out + O_CP, out + O_CS);
            else if (pn < 14) epi_in_kind<0>(acc, row0, (pn - 10) * 256, wc, fq, ss, (bf16_t*)(w_ + WS_QS), DM, nullptr, nullptr, nullptr, nullptr);
            else if (pn < 18) epi_in_kind<3>(acc, row0, (pn - 14) * 256, wc, fq, ss, (bf16_t*)(w_ + WS_KK), DM, (float*)(w_ + WS_LOGF), stats + ST_LB, nullptr, nullptr);
            else if (pn < 22) epi_in_kind<1>(acc, row0, (pn - 18) * 256, wc, fq, ss, (bf16_t*)(w_ + WS_VV), DM, nullptr, nullptr, nullptr, nullptr);
            else if (pn < 26) epi_in_kind<0>(acc, row0, (pn - 22) * 256, wc, fq, ss, (bf16_t*)(w_ + WS_OGS), DM, nullptr, nullptr, nullptr, nullptr);
            else epi_in_kind<4>(acc, row0, 0, wc, fq, ss, nullptr, 0, (float*)(w_ + WS_DT), stats + ST_DTB, nullptr, nullptr);
        }
        else if (ph == PH_PLE) epi_e(acc, u, wr, wc, fr, fq, (float*)(w_ + WS_E), stats + ST_SSE);
        else epi_gate(acc, u, wr, wc, fr, fq, stats + ST_SS3, (const float*)(w_ + WS_E), stats + ST_SSE, stats + ST_POST, XR, out + O_Y, stats + ST_SS4);
    }
};
}

__device__ __forceinline__ void tr_item(const float* W, int K, int Nsrc, int k0, int c0, int nvalid, bf16* WT, int drow0, const float* ks, LAS float* scr, int lane) {
#pragma unroll 8
    for (int i = 0; i < 32; ++i) { const int kk = 2 * i + (lane >> 5), cc = lane & 31;
        float v = (cc < nvalid) ? W[(size_t)(k0 + kk) * Nsrc + c0 + cc] : 0.f; if (ks) v *= ks[kk]; scr[kk * 33 + cc] = v; }
    LDS_WAIT(); asm volatile("" ::: "memory");
    const int c = lane & 7;
#pragma unroll
    for (int j = 0; j < 4; ++j) { const int n = (lane >> 3) + 8 * j; const LAS float* s = scr + (8 * c) * 33 + n;
        v4u o; o.x = pk2(s[0 * 33], s[1 * 33]); o.y = pk2(s[2 * 33], s[3 * 33]); o.z = pk2(s[4 * 33], s[5 * 33]); o.w = pk2(s[6 * 33], s[7 * 33]);
        *(GAS v4u*)(WT + (size_t)(drow0 + n) * K + k0 + 8 * c) = o; }
    LDS_WAIT(); asm volatile("" ::: "memory");
}

struct Args { const float* in[29]; float* out; unsigned char* ws; int ph_lo, ph_hi; };

__device__ __forceinline__ void p0_prologue(const Args& A, LAS unsigned char* lds, int vcu, int G) {
    const int tid = tid_op(), lane = tid & 63, wave = __builtin_amdgcn_readfirstlane(tid >> 6);
    LAS float* scr = (LAS float*)(lds + wave * 16384);
    const int gw = vcu * NWAVES + wave, NGW = G * NWAVES;
    unsigned char* ws = A.ws;
    bf16* W1U = (bf16*)(ws + WS_W1U); bf16* W1D = (bf16*)(ws + WS_W1D); bf16* WIN = (bf16*)(ws + WS_WIN); bf16* WOUT = (bf16*)(ws + WS_WOUT);
    bf16* W2U = (bf16*)(ws + WS_W2U); bf16* W2D = (bf16*)(ws + WS_W2D); bf16* WG = (bf16*)(ws + WS_WG); bf16* WP = (bf16*)(ws + WS_WP);
    constexpr int I_UP = 16 * 176, I_DN = 44 * 32, I_IN = 16 * 216, I_OUT = 32 * 32, I_G = 16 * 32, I_P = 4 * 32;
    constexpr int NITEMS = 2 * I_UP + 2 * I_DN + I_IN + I_OUT + I_G + I_P;
    for (int it = gw; it < NITEMS; it += NGW) {
        int r = it;
        if (r < 2 * I_UP) {
            const int which = r / I_UP; r -= which * I_UP; const int kb = r / 176, nb = r % 176, drow = nb * 32;
            const int t = drow >> 8, rem = drow & 255, h = rem >> 7, i = rem & 127;
            tr_item(which ? A.in[22] : A.in[8], 1024, 2 * DFF, kb * 64, h * DFF + t * 128 + i, 32, which ? W2U : W1U, drow, (which ? A.in[21] : A.in[7]) + kb * 64, scr, lane); continue; }
        r -= 2 * I_UP;
        if (r < 2 * I_DN) { const int which = r / I_DN; r -= which * I_DN; const int kb = r / 32, nb = r % 32;
            tr_item(which ? A.in[23] : A.in[9], DFF, 1024, kb * 64, nb * 32, 32, which ? W2D : W1D, nb * 32, nullptr, scr, lane); continue; }
        r -= 2 * I_DN;
        if (r < I_IN) { const int kb = r / 216, nb = r % 216, drow = nb * 32; int c0, nv = 32;
            if (drow < 2560) c0 = drow; else if (drow < 6656) c0 = drow + 16; else if (drow == 6656) { c0 = 2560; nv = 16; } else { c0 = 0; nv = 0; }
            tr_item(A.in[11], 1024, DIN, kb * 64, c0, nv, WIN, drow, A.in[10] + kb * 64, scr, lane); continue; }
        r -= I_IN;
        if (r < I_OUT) { const int kb = r / 32, nb = r % 32, k0 = kb * 64;
            tr_item(A.in[20], 2048, 1024, k0, nb * 32, 32, WOUT, nb * 32, k0 < 1024 ? A.in[17] + k0 : A.in[19] + (k0 - 1024), scr, lane); continue; }
        r -= I_OUT;
        if (r < I_G) { const int kb = r / 32, nb = r % 32;
            tr_item(A.in[25], 1024, 1024, kb * 64, nb * 32, 32, WG, nb * 32, A.in[24] + kb * 64, scr, lane); continue; }
        r -= I_G;
        { const int kb = r / 32, nb = r % 32; tr_item(A.in[26], PLE, 1024, kb * 64, nb * 32, 32, WP, nb * 32, nullptr, scr, lane); }
    }
    float* stats = (float*)(ws + WS_STATS);
    bf16* XB = (bf16*)(ws + WS_XB); bf16* PB = (bf16*)(ws + WS_PB);
    for (int m = gw; m < MT; m += NGW) {
        const float* xrow = (m < MP) ? A.in[0] + (size_t)m * DM : A.in[1] + (size_t)(m - MP) * DM;
        const GAS f32x4* xr = (const GAS f32x4*)xrow + lane;
        f32x4 v[4]; float s = 0.f;
#pragma unroll
        for (int j = 0; j < 4; ++j) { v[j] = xr[64 * j]; s += (v[j].x * v[j].x + v[j].y * v[j].y) + (v[j].z * v[j].z + v[j].w * v[j].w); }
        s = wave_sum(s);
        if (lane == 0) stats[ST_SS0 + m] = s;
        GAS unsigned long long* o8 = (GAS unsigned long long*)(XB + (size_t)m * DM) + lane;
#pragma unroll
        for (int j = 0; j < 4; ++j) o8[64 * j] = (unsigned long long)pk2(v[j].x, v[j].y) | ((unsigned long long)pk2(v[j].z, v[j].w) << 32);
        const float* prow = (m < MP) ? A.in[5] + (size_t)m * PLE : A.in[6] + (size_t)(m - MP) * PLE;
        const f32x4 pv = ((const GAS f32x4*)prow)[lane];
        ((GAS unsigned long long*)(PB + (size_t)m * PLE))[lane] = (unsigned long long)pk2(pv.x, pv.y) | ((unsigned long long)pk2(pv.z, pv.w) << 32);
    }
    const int gt = vcu * NTHR + tid, NGT = G * NTHR;
    for (int i = gt; i < 15 * MT; i += NGT) stats[MT + i] = 0.f;
    for (int i = gt; i < 1024; i += NGT) { stats[ST_LB + i] = 1.0f / (1.0f + __expf(A.in[18][1024 + i] - A.in[18][i])); stats[ST_POST + i] = A.in[27][i]; }
    if (gt < 16) stats[ST_DTB + gt] = A.in[14][gt];
}

__device__ __forceinline__ void unpack8(const v4u w, float (&f)[8]) {
    f[0] = bf2f((bf16)(w.x & 0xffff)); f[1] = bf2f((bf16)(w.x >> 16)); f[2] = bf2f((bf16)(w.y & 0xffff)); f[3] = bf2f((bf16)(w.y >> 16));
    f[4] = bf2f((bf16)(w.z & 0xffff)); f[5] = bf2f((bf16)(w.z >> 16)); f[6] = bf2f((bf16)(w.w & 0xffff)); f[7] = bf2f((bf16)(w.w >> 16));
}
__device__ __forceinline__ v4u pack8(const float (&f)[8]) { v4u o; o.x = pk2(f[0], f[1]); o.y = pk2(f[2], f[3]); o.z = pk2(f[4], f[5]); o.w = pk2(f[6], f[7]); return o; }
__device__ __forceinline__ void p4_conv(const Args& A, int vcu, int G) {
    const int tid = tid_op(), gt = vcu * NTHR + tid, NGT = G * NTHR;
    const bf16* XBC = (const bf16*)(A.ws + WS_XBC); bf16* CONV = (bf16*)(A.ws + WS_CONV);
    const float* conv_w = A.in[12]; const float* conv_b = A.in[13];
    constexpr int NCG = CONVD / 8, NSTRIP = MP / 8;
    for (int u = gt; u < NSTRIP * NCG; u += NGT) {
        const int cg = u % NCG, strip = u / NCG, r0 = strip * 8, tseq = r0 & (SEQ - 1), c = cg * 8;
        float wgt[4][8], bias[8];
#pragma unroll
        for (int j = 0; j < 4; ++j) { const f32x4 a = *(const f32x4*)(conv_w + j * CONVD + c), b = *(const f32x4*)(conv_w + j * CONVD + c + 4);
            wgt[j][0] = a.x; wgt[j][1] = a.y; wgt[j][2] = a.z; wgt[j][3] = a.w; wgt[j][4] = b.x; wgt[j][5] = b.y; wgt[j][6] = b.z; wgt[j][7] = b.w; }
        { const f32x4 a = *(const f32x4*)(conv_b + c), b = *(const f32x4*)(conv_b + c + 4); bias[0] = a.x; bias[1] = a.y; bias[2] = a.z; bias[3] = a.w; bias[4] = b.x; bias[5] = b.y; bias[6] = b.z; bias[7] = b.w; }
        v4u raw[11];
#pragma unroll
        for (int i = 0; i < 11; ++i) { const bool ok = (tseq - 3 + i) >= 0;
            raw[i] = ok ? *(const GAS v4u*)(XBC + (size_t)(r0 - 3 + i) * CONVD + c) : (v4u){0u, 0u, 0u, 0u}; }
#pragma unroll
        for (int j = 0; j < 8; ++j) {
            float acc[8];
#pragma unroll
            for (int e = 0; e < 8; ++e) acc[e] = bias[e];
#pragma unroll
            for (int jj = 0; jj < 4; ++jj) { float f[8]; unpack8(raw[j + jj], f);
#pragma unroll
                for (int e = 0; e < 8; ++e) acc[e] += wgt[jj][e] * f[e]; }
#pragma unroll
            for (int e = 0; e < 8; ++e) acc[e] = siluf(acc[e]);
            *(GAS v4u*)(CONV + (size_t)(r0 + j) * CONVD + c) = pack8(acc);
        }
    }
}

typedef float f32x16 __attribute__((ext_vector_type(16)));
typedef unsigned u32x2 __attribute__((ext_vector_type(2)));
typedef float f32x2g __attribute__((ext_vector_type(2)));
#define MFMA32(a, b, c) __builtin_amdgcn_mfma_f32_32x32x16_bf16(a, b, c, 0, 0, 0)
#define LDS_FRAG(base, row, k) (*(const LAS bf16x8*)(lds + (base) + (row) * 272 + (k) * 2))
#define LDS_FRAG64(base, row, k) (*(const LAS bf16x8*)(lds + (base) + (row) * 144 + (k) * 2))
constexpr int SSD_L_CM = 0, SSD_L_BM = 34816, SSD_L_BT = 69632, SSD_L_XT = 104448, SSD_L_HB = 121856, SSD_L_F = 139264;
static_assert(SSD_L_F + 2048 <= LDSCTL_OFF, "SSD chain LDS image vs the control words");
__device__ __forceinline__ void ssd_chain(const Args& A, LAS unsigned char* lds, int b, int h) {
    const int tid = tid_op(), lane = tid & 63, w = __builtin_amdgcn_readfirstlane(tid >> 6), l31 = lane & 31, lh = lane >> 5, g = h >> 3;
    const bf16* CONV = (const bf16*)(A.ws + WS_CONV); const float* DT = (const float*)(A.ws + WS_DT); bf16* MIX = (bf16*)(A.ws + WS_MIX);
    const float a = -__expf(A.in[15][h]), dsk = A.in[16][h];
    LAS float* acs = (LAS float*)(lds + SSD_L_F); LAS float* dtv = acs + 128; LAS float* sc = acs + 256; LAS float* eacs = acs + 384;
    f32x16 hacc;
#pragma unroll
    for (int i = 0; i < 16; ++i) hacc[i] = 0.f;
    for (int c = 0; c < SEQ / 128; ++c) {
        const int r0 = b * SEQ + c * 128;
        __syncthreads();
#pragma unroll
        for (int i = 0; i < 4; ++i) { const int piece = tid + NTHR * i, row = piece >> 4, pc = piece & 15;
            const v4u cv = *(const GAS v4u*)(CONV + (size_t)(r0 + row) * CONVD + 1280 + g * 128 + pc * 8);
            const v4u bv = *(const GAS v4u*)(CONV + (size_t)(r0 + row) * CONVD + 1024 + g * 128 + pc * 8);
            *(LAS v4u*)(lds + SSD_L_CM + row * 272 + pc * 16) = cv; *(LAS v4u*)(lds + SSD_L_BM + row * 272 + pc * 16) = bv; }
        { unsigned r[16];
#pragma unroll
            for (int j = 0; j < 16; ++j) r[j] = *(const GAS unsigned*)(CONV + (size_t)(r0 + 16 * w + j) * CONVD + 1024 + g * 128 + 2 * lane);
            v4u lo0, lo1, hi0, hi1;
            lo0.x = (r[0] & 0xffffu) | (r[1] << 16); lo0.y = (r[2] & 0xffffu) | (r[3] << 16); lo0.z = (r[4] & 0xffffu) | (r[5] << 16); lo0.w = (r[6] & 0xffffu) | (r[7] << 16);
            lo1.x = (r[8] & 0xffffu) | (r[9] << 16); lo1.y = (r[10] & 0xffffu) | (r[11] << 16); lo1.z = (r[12] & 0xffffu) | (r[13] << 16); lo1.w = (r[14] & 0xffffu) | (r[15] << 16);
            hi0.x = (r[0] >> 16) | (r[1] & 0xffff0000u); hi0.y = (r[2] >> 16) | (r[3] & 0xffff0000u); hi0.z = (r[4] >> 16) | (r[5] & 0xffff0000u); hi0.w = (r[6] >> 16) | (r[7] & 0xffff0000u);
            hi1.x = (r[8] >> 16) | (r[9] & 0xffff0000u); hi1.y = (r[10] >> 16) | (r[11] & 0xffff0000u); hi1.z = (r[12] >> 16) | (r[13] & 0xffff0000u); hi1.w = (r[14] >> 16) | (r[15] & 0xffff0000u);
            *(LAS v4u*)(lds + SSD_L_BT + (2 * lane) * 272 + 32 * w) = lo0; *(LAS v4u*)(lds + SSD_L_BT + (2 * lane) * 272 + 32 * w + 16) = lo1;
            *(LAS v4u*)(lds + SSD_L_BT + (2 * lane + 1) * 272 + 32 * w) = hi0; *(LAS v4u*)(lds + SSD_L_BT + (2 * lane + 1) * 272 + 32 * w + 16) = hi1; }
        { unsigned r[8];
#pragma unroll
            for (int j = 0; j < 8; ++j) r[j] = *(const GAS unsigned*)(CONV + (size_t)(r0 + 16 * w + 8 * lh + j) * CONVD + h * 64 + 2 * l31);
            v4u lo, hi;
            lo.x = (r[0] & 0xffffu) | (r[1] << 16); lo.y = (r[2] & 0xffffu) | (r[3] << 16); lo.z = (r[4] & 0xffffu) | (r[5] << 16); lo.w = (r[6] & 0xffffu) | (r[7] << 16);
            hi.x = (r[0] >> 16) | (r[1] & 0xffff0000u); hi.y = (r[2] >> 16) | (r[3] & 0xffff0000u); hi.z = (r[4] >> 16) | (r[5] & 0xffff0000u); hi.w = (r[6] >> 16) | (r[7] & 0xffff0000u);
            *(LAS v4u*)(lds + SSD_L_XT + (2 * l31) * 272 + (16 * w + 8 * lh) * 2) = lo; *(LAS v4u*)(lds + SSD_L_XT + (2 * l31 + 1) * 272 + (16 * w + 8 * lh) * 2) = hi; }
        if (w == 0) {
            const float d0 = DT[(size_t)(r0 + 2 * lane) * 16 + h], d1 = DT[(size_t)(r0 + 2 * lane + 1) * 16 + h];
            const float x0 = d0 * a, x1 = d1 * a; float ps = x0 + x1;
#pragma unroll
            for (int o = 1; o < 64; o <<= 1) { const float t = __shfl_up(ps, o); if (lane >= o) ps += t; }
            acs[2 * lane] = ps - x1; acs[2 * lane + 1] = ps; dtv[2 * lane] = d0; dtv[2 * lane + 1] = d1;
        }
        __syncthreads();
        const float acs_last = acs[127];
        if (tid < 128) { sc[tid] = dtv[tid] * __expf(acs_last - acs[tid]); eacs[tid] = __expf(acs[tid]); }
        unsigned wreg[2][8];
#pragma unroll
        for (int ti = 0; ti < 2; ++ti) { const int tile = 2 * w + ti, st = tile >> 2, tt = tile & 3;
            if (st <= tt) {
                f32x16 acc;
#pragma unroll
                for (int i = 0; i < 16; ++i) acc[i] = 0.f;
#pragma unroll
                for (int ks = 0; ks < 8; ++ks) acc = MFMA32(LDS_FRAG(SSD_L_BM, 32 * st + l31, 16 * ks + 8 * lh), LDS_FRAG(SSD_L_CM, 32 * tt + l31, 16 * ks + 8 * lh), acc);
                const int t = 32 * tt + l31; const float at = acs[t];
#pragma unroll
                for (int q = 0; q < 4; ++q) { const int s0 = 32 * st + 8 * q + 4 * lh;
                    const f32x4 as4 = *(const LAS f32x4*)(acs + s0), d4 = *(const LAS f32x4*)(dtv + s0); float v[4];
#pragma unroll
                    for (int j = 0; j < 4; ++j) { const int s = s0 + j; float wv = (s <= t) ? acc[4 * q + j] * __expf(at - as4[j]) * d4[j] : 0.f; if (s == t) wv += dsk; v[j] = wv; }
                    wreg[ti][2 * q] = pk2(v[0], v[1]); wreg[ti][2 * q + 1] = pk2(v[2], v[3]); }
            }
        }
        __syncthreads();
#pragma unroll
        for (int ti = 0; ti < 2; ++ti) { const int tile = 2 * w + ti, st = tile >> 2, tt = tile & 3;
            if (st <= tt) { const int t = 32 * tt + l31;
#pragma unroll
                for (int q = 0; q < 4; ++q) *(LAS u32x2*)(lds + SSD_L_BM + t * 272 + (32 * st + 8 * q + 4 * lh) * 2) = (u32x2){wreg[ti][2 * q], wreg[ti][2 * q + 1]}; } }
        __syncthreads();
        { const int pt = w & 1, tt = w >> 1; f32x16 acc;
#pragma unroll
            for (int i = 0; i < 16; ++i) acc[i] = 0.f;
            if (c > 0) {
#pragma unroll
                for (int ks = 0; ks < 8; ++ks) acc = MFMA32(LDS_FRAG(SSD_L_HB, 32 * pt + l31, 16 * ks + 8 * lh), LDS_FRAG(SSD_L_CM, 32 * tt + l31, 16 * ks + 8 * lh), acc);
                const float e = eacs[32 * tt + l31];
#pragma unroll
                for (int i = 0; i < 16; ++i) acc[i] *= e;
            }
            for (int ks = 0; ks < 2 * (tt + 1); ++ks) acc = MFMA32(LDS_FRAG(SSD_L_XT, 32 * pt + l31, 16 * ks + 8 * lh), LDS_FRAG(SSD_L_BM, 32 * tt + l31, 16 * ks + 8 * lh), acc);
            const size_t row = (size_t)(r0 + 32 * tt + l31);
#pragma unroll
            for (int q = 0; q < 4; ++q) *(GAS u32x2*)(MIX + row * 2048 + h * 64 + 32 * pt + 8 * q + 4 * lh) = (u32x2){pk2(acc[4 * q], acc[4 * q + 1]), pk2(acc[4 * q + 2], acc[4 * q + 3])};
        }
        __syncthreads();
#pragma unroll
        for (int i = 0; i < 2; ++i) { const int piece = tid + NTHR * i, p = piece >> 4, pc = piece & 15;
            LAS v4u* px = (LAS v4u*)(lds + SSD_L_XT + p * 272 + pc * 16); float f[8]; unpack8(*px, f);
            const f32x4 s0 = *(const LAS f32x4*)(sc + 8 * pc), s1 = *(const LAS f32x4*)(sc + 8 * pc + 4);
            f[0] *= s0.x; f[1] *= s0.y; f[2] *= s0.z; f[3] *= s0.w; f[4] *= s1.x; f[5] *= s1.y; f[6] *= s1.z; f[7] *= s1.w;
            *px = pack8(f); }
        __syncthreads();
        { const int nt = w >> 1, pt = w & 1; const float dc = __expf(acs_last);
#pragma unroll
            for (int i = 0; i < 16; ++i) hacc[i] *= dc;
#pragma unroll
            for (int ks = 0; ks < 8; ++ks) hacc = MFMA32(LDS_FRAG(SSD_L_BT, 32 * nt + l31, 16 * ks + 8 * lh), LDS_FRAG(SSD_L_XT, 32 * pt + l31, 16 * ks + 8 * lh), hacc);
#pragma unroll
            for (int q = 0; q < 4; ++q) *(LAS u32x2*)(lds + SSD_L_HB + (32 * pt + l31) * 272 + (32 * nt + 8 * q + 4 * lh) * 2) = (u32x2){pk2(hacc[4 * q], hacc[4 * q + 1]), pk2(hacc[4 * q + 2], hacc[4 * q + 3])};
        }
    }
    { const int nt = w >> 1, pt = w & 1; float* o = A.out + O_SP + ((size_t)(b * SH + h) * SP + 32 * pt + l31) * SN + 32 * nt + 4 * lh;
#pragma unroll
        for (int q = 0; q < 4; ++q) *(f32x4*)(o + 8 * q) = (f32x4){hacc[4 * q], hacc[4 * q + 1], hacc[4 * q + 2], hacc[4 * q + 3]}; }
}
constexpr int GL_QE = 0, GL_KE = 17408, GL_KDT = 34816, GL_VT = 53248, GL_ATT = 71680, GL_SB = 80896, GL_TOT = 115712, GL_DEC = 119808;
__device__ __forceinline__ void gla_chain(const Args& A, LAS unsigned char* lds, int b, int h) {
    const int tid = tid_op(), lane = tid & 63, w = __builtin_amdgcn_readfirstlane(tid >> 6), l31 = lane & 31, lh = lane >> 5;
    const bf16* QS = (const bf16*)(A.ws + WS_QS); const bf16* KK = (const bf16*)(A.ws + WS_KK); const bf16* VV = (const bf16*)(A.ws + WS_VV); const float* LOGF = (const float*)(A.ws + WS_LOGF);
    bf16* MIX = (bf16*)(A.ws + WS_MIX);
    LAS float* tot = (LAS float*)(lds + GL_TOT); LAS float* dec = (LAS float*)(lds + GL_DEC);
    const int kt = w >> 1, vt0 = 2 * (w & 1);
    f32x16 S0, S1;
#pragma unroll
    for (int i = 0; i < 16; ++i) { S0[i] = 0.f; S1[i] = 0.f; }
    for (int c = 0; c < SEQ / 64; ++c) {
        const int r0 = b * SEQ + c * 64;
        __syncthreads();
        float lf0[8], lf1[8]; unsigned qv[8], kv[8], vv[8];
#pragma unroll
        for (int j = 0; j < 8; ++j) { const size_t off = (size_t)(r0 + 8 * w + j) * DM + h * 128 + 2 * lane;
            const f32x2g lf = *(const GAS f32x2g*)(LOGF + off); lf0[j] = lf.x; lf1[j] = lf.y;
            qv[j] = *(const GAS unsigned*)(QS + off); kv[j] = *(const GAS unsigned*)(KK + off); vv[j] = *(const GAS unsigned*)(VV + off); }
#pragma unroll
        for (int j = 1; j < 8; ++j) { lf0[j] += lf0[j - 1]; lf1[j] += lf1[j - 1]; }
        *(LAS f32x2g*)(tot + w * 128 + 2 * lane) = (f32x2g){lf0[7], lf1[7]};
        { v4u lo, hi;
            lo.x = (vv[0] & 0xffffu) | (vv[1] << 16); lo.y = (vv[2] & 0xffffu) | (vv[3] << 16); lo.z = (vv[4] & 0xffffu) | (vv[5] << 16); lo.w = (vv[6] & 0xffffu) | (vv[7] << 16);
            hi.x = (vv[0] >> 16) | (vv[1] & 0xffff0000u); hi.y = (vv[2] >> 16) | (vv[3] & 0xffff0000u); hi.z = (vv[4] >> 16) | (vv[5] & 0xffff0000u); hi.w = (vv[6] >> 16) | (vv[7] & 0xffff0000u);
            *(LAS v4u*)(lds + GL_VT + (2 * lane) * 144 + 16 * w) = lo; *(LAS v4u*)(lds + GL_VT + (2 * lane + 1) * 144 + 16 * w) = hi; }
        __syncthreads();
        float off0 = 0.f, off1 = 0.f, t0s = 0.f, t1s = 0.f;
#pragma unroll
        for (int ww = 0; ww < 8; ++ww) { const f32x2g tv = *(const LAS f32x2g*)(tot + ww * 128 + 2 * lane); if (ww < w) { off0 += tv.x; off1 += tv.y; } t0s += tv.x; t1s += tv.y; }
        if (w == 0) *(LAS f32x2g*)(dec + 2 * lane) = (f32x2g){__expf(t0s), __expf(t1s)};
        { float kd0[8], kd1[8];
#pragma unroll
            for (int j = 0; j < 8; ++j) { const float b0 = off0 + lf0[j], b1 = off1 + lf1[j];
                const float q0 = bf2f((bf16)(qv[j] & 0xffffu)), q1 = bf2f((bf16)(qv[j] >> 16)), k0 = bf2f((bf16)(kv[j] & 0xffffu)), k1 = bf2f((bf16)(kv[j] >> 16));
                *(LAS unsigned*)(lds + GL_QE + (8 * w + j) * 272 + 4 * lane) = pk2(q0 * __expf(b0), q1 * __expf(b1));
                *(LAS unsigned*)(lds + GL_KE + (8 * w + j) * 272 + 4 * lane) = pk2(k0 * __expf(-b0), k1 * __expf(-b1));
                kd0[j] = k0 * __expf(t0s - b0); kd1[j] = k1 * __expf(t1s - b1); }
            *(LAS v4u*)(lds + GL_KDT + (2 * lane) * 144 + 16 * w) = pack8(kd0); *(LAS v4u*)(lds + GL_KDT + (2 * lane + 1) * 144 + 16 * w) = pack8(kd1); }
        __syncthreads();
        if (w < 4) { const int st = w >> 1, tt = w & 1;
            if (st <= tt) { f32x16 acc;
#pragma unroll
                for (int i = 0; i < 16; ++i) acc[i] = 0.f;
#pragma unroll
                for (int ks = 0; ks < 8; ++ks) acc = MFMA32(LDS_FRAG(GL_KE, 32 * st + l31, 16 * ks + 8 * lh), LDS_FRAG(GL_QE, 32 * tt + l31, 16 * ks + 8 * lh), acc);
                const int t = 32 * tt + l31;
#pragma unroll
                for (int q = 0; q < 4; ++q) { const int s0 = 32 * st + 8 * q + 4 * lh; float v[4];
#pragma unroll
                    for (int j = 0; j < 4; ++j) v[j] = (s0 + j <= t) ? acc[4 * q + j] : 0.f;
                    *(LAS u32x2*)(lds + GL_ATT + t * 144 + s0 * 2) = (u32x2){pk2(v[0], v[1]), pk2(v[2], v[3])}; } } }
        const int ovt = w >> 1, ott = w & 1; f32x16 oacc;
#pragma unroll
        for (int i = 0; i < 16; ++i) oacc[i] = 0.f;
        if (c > 0) {
#pragma unroll
            for (int ks = 0; ks < 8; ++ks) oacc = MFMA32(LDS_FRAG(GL_SB, 32 * ovt + l31, 16 * ks + 8 * lh), LDS_FRAG(GL_QE, 32 * ott + l31, 16 * ks + 8 * lh), oacc);
        }
        __syncthreads();
        for (int ks = 0; ks < 2 * (ott + 1); ++ks) oacc = MFMA32(LDS_FRAG64(GL_VT, 32 * ovt + l31, 16 * ks + 8 * lh), LDS_FRAG64(GL_ATT, 32 * ott + l31, 16 * ks + 8 * lh), oacc);
        { const size_t row = (size_t)(r0 + 32 * ott + l31);
#pragma unroll
            for (int q = 0; q < 4; ++q) *(GAS u32x2*)(MIX + row * 2048 + 1024 + h * 128 + 32 * ovt + 8 * q + 4 * lh) = (u32x2){pk2(oacc[4 * q], oacc[4 * q + 1]), pk2(oacc[4 * q + 2], oacc[4 * q + 3])}; }
#pragma unroll
        for (int q = 0; q < 4; ++q) { const f32x4 d4 = *(const LAS f32x4*)(dec + 32 * kt + 8 * q + 4 * lh);
#pragma unroll
            for (int j = 0; j < 4; ++j) { S0[4 * q + j] *= d4[j]; S1[4 * q + j] *= d4[j]; } }
#pragma unroll
        for (int ks = 0; ks < 4; ++ks) { const bf16x8 af = LDS_FRAG64(GL_KDT, 32 * kt + l31, 16 * ks + 8 * lh);
            S0 = MFMA32(af, LDS_FRAG64(GL_VT, 32 * vt0 + l31, 16 * ks + 8 * lh), S0); S1 = MFMA32(af, LDS_FRAG64(GL_VT, 32 * (vt0 + 1) + l31, 16 * ks + 8 * lh), S1); }
#pragma unroll
        for (int q = 0; q < 4; ++q) {
            *(LAS u32x2*)(lds + GL_SB + (32 * vt0 + l31) * 272 + (32 * kt + 8 * q + 4 * lh) * 2) = (u32x2){pk2(S0[4 * q], S0[4 * q + 1]), pk2(S0[4 * q + 2], S0[4 * q + 3])};
            *(LAS u32x2*)(lds + GL_SB + (32 * (vt0 + 1) + l31) * 272 + (32 * kt + 8 * q + 4 * lh) * 2) = (u32x2){pk2(S1[4 * q], S1[4 * q + 1]), pk2(S1[4 * q + 2], S1[4 * q + 3])}; }
    }
    { float* o = A.out + O_HP + (size_t)(b * HH + h) * (HK * HV);
#pragma unroll
        for (int q = 0; q < 4; ++q)
#pragma unroll
            for (int j = 0; j < 4; ++j) { const int k = 32 * kt + 8 * q + 4 * lh + j; o[(size_t)k * HV + 32 * vt0 + l31] = S0[4 * q + j]; o[(size_t)k * HV + 32 * (vt0 + 1) + l31] = S1[4 * q + j]; } }
}
constexpr int SSD_TC = 4, GLA_TC = 4;
__device__ __forceinline__ void ssd_item(const Args& A, LAS unsigned char* lds, int s, int h) {
    const int tid = tid_op(), p = tid >> 3, nq = tid & 7, g = h >> 3;
    const int L = DSEQ; const int rowbase = MP + (s - NBP) * DSEQ;
    unsigned char* ws = A.ws;
    const bf16* XBC = (const bf16*)(ws + WS_XBC); const float* DT = (const float*)(ws + WS_DT);
    bf16* MIX = (bf16*)(ws + WS_MIX);
    const float* conv_w = A.in[12]; const float* conv_b = A.in[13]; const float* conv0 = A.in[2];
    LAS float* xs = (LAS float*)lds; LAS float* Bs = xs + SSD_TC * 64; LAS float* Cs = Bs + SSD_TC * 128; LAS float* yo = Cs + SSD_TC * 128; LAS float* dts = yo + SSD_TC * 64;
    float hst[16];
    { const float* h0 = A.in[3] + ((size_t)(s - NBP) * SH + h) * (SP * SN) + p * SN + nq * 16;
#pragma unroll
        for (int i = 0; i < 4; ++i) { const f32x4 t4 = *(const f32x4*)(h0 + 4 * i); hst[4 * i] = t4.x; hst[4 * i + 1] = t4.y; hst[4 * i + 2] = t4.z; hst[4 * i + 3] = t4.w; } }
    const float a = -__expf(A.in[15][h]), dsk = A.in[16][h];
    {
        const int nT = L;
        __syncthreads();
        for (int idx = tid; idx < nT * 320; idx += NTHR) {
            const int t = idx / 320, c = idx - t * 320;
            const int col = c < 64 ? h * 64 + c : (c < 192 ? 1024 + g * 128 + (c - 64) : 1280 + g * 128 + (c - 192));
            float av = conv_b[col];
#pragma unroll
            for (int j = 0; j < 4; ++j) { const int tt = t + j - 3; float r;
                if (tt >= 0) r = bf2f(XBC[(size_t)(rowbase + tt) * CONVD + col]); else r = conv0[((size_t)(s - NBP) * 3 + (3 + tt)) * CONVD + col];
                av += conv_w[j * CONVD + col] * r; }
            const float v = siluf(av);
            if (c < 64) xs[t * 64 + c] = v; else if (c < 192) Bs[t * 128 + (c - 64)] = v; else Cs[t * 128 + (c - 192)] = v;
        }
        if (tid < nT) dts[tid] = DT[(size_t)(rowbase + tid) * 16 + h];
        __syncthreads();
        for (int t = 0; t < nT; ++t) {
            const float dt = dts[t], dA = __expf(dt * a), xv = xs[t * 64 + p], dx = dt * xv; float y = 0.f;
#pragma unroll
            for (int i = 0; i < 16; ++i) { hst[i] = hst[i] * dA + dx * Bs[t * 128 + nq * 16 + i]; y += hst[i] * Cs[t * 128 + nq * 16 + i]; }
            y += __shfl_xor(y, 1); y += __shfl_xor(y, 2); y += __shfl_xor(y, 4);
            if (nq == 0) yo[t * 64 + p] = y + dsk * xv;
        }
        __syncthreads();
        for (int idx = tid; idx < nT * 64; idx += NTHR) {
            const int t = idx >> 6, pp = idx & 63; const size_t row = (size_t)(rowbase + t);
            MIX[row * 2048 + h * 64 + pp] = (bf16)f2bf(yo[idx]);
        }
    }
    float* hout = A.out + O_SS + ((size_t)(s - NBP) * SH + h) * (SP * SN) + p * SN + nq * 16;
#pragma unroll
    for (int i = 0; i < 4; ++i) *(f32x4*)(hout + 4 * i) = (f32x4){hst[4 * i], hst[4 * i + 1], hst[4 * i + 2], hst[4 * i + 3]};
}
__device__ __forceinline__ void gla_item(const Args& A, LAS unsigned char* lds, int s, int h) {
    const int tid = tid_op(), lane = tid & 63, wave = __builtin_amdgcn_readfirstlane(tid >> 6), kg = tid >> 5, vq = tid & 31;
    const int L = DSEQ; const int rowbase = MP + (s - NBP) * DSEQ;
    unsigned char* ws = A.ws;
    const bf16* QS = (const bf16*)(ws + WS_QS); const bf16* KK = (const bf16*)(ws + WS_KK); const bf16* VV = (const bf16*)(ws + WS_VV); const float* LOGF = (const float*)(ws + WS_LOGF);
    bf16* MIX = (bf16*)(ws + WS_MIX);
    LAS float* qs = (LAS float*)lds; LAS float* ks = qs + GLA_TC * 128; LAS float* fs = ks + GLA_TC * 128; LAS float* vs = fs + GLA_TC * 128; LAS float* op = vs + GLA_TC * 128;
    float S[8][4];
    { const float* s0 = A.in[4] + ((size_t)(s - NBP) * HH + h) * (HK * HV) + (size_t)(kg * 8) * HV + 4 * vq;
#pragma unroll
        for (int i = 0; i < 8; ++i) { const f32x4 t4 = *(const f32x4*)(s0 + i * HV); S[i][0] = t4.x; S[i][1] = t4.y; S[i][2] = t4.z; S[i][3] = t4.w; } }
    {
        const int nT = L;
        __syncthreads();
        for (int idx = tid; idx < nT * 128; idx += NTHR) {
            const int t = idx >> 7, c = idx & 127; const size_t o = (size_t)(rowbase + t) * DM + h * 128 + c;
            qs[idx] = bf2f(QS[o]); ks[idx] = bf2f(KK[o]); fs[idx] = __expf(LOGF[o]); vs[idx] = bf2f(VV[o]);
        }
        __syncthreads();
        for (int t = 0; t < nT; ++t) {
            const f32x4 v4 = *(const LAS f32x4*)(vs + t * 128 + 4 * vq); f32x4 o4 = (f32x4){0.f, 0.f, 0.f, 0.f};
#pragma unroll
            for (int i = 0; i < 8; ++i) { const int k = t * 128 + kg * 8 + i; const float f = fs[k], kv = ks[k], qv = qs[k];
#pragma unroll
                for (int j = 0; j < 4; ++j) { S[i][j] = f * S[i][j] + kv * v4[j]; o4[j] += qv * S[i][j]; } }
#pragma unroll
            for (int j = 0; j < 4; ++j) o4[j] += __shfl_xor(o4[j], 32);
            if (lane < 32) *(LAS f32x4*)(op + (t * 8 + wave) * 128 + 4 * vq) = o4;
        }
        __syncthreads();
        for (int idx = tid; idx < nT * 128; idx += NTHR) {
            const int t = idx >> 7, c = idx & 127; float o = 0.f;
#pragma unroll
            for (int ww = 0; ww < 8; ++ww) o += op[(t * 8 + ww) * 128 + c];
            const size_t row = (size_t)(rowbase + t);
            MIX[row * 2048 + 1024 + h * 128 + c] = (bf16)f2bf(o);
        }
    }
    float* sout = A.out + O_HS + ((size_t)(s - NBP) * HH + h) * (HK * HV) + (size_t)(kg * 8) * HV + 4 * vq;
#pragma unroll
    for (int i = 0; i < 8; ++i) *(f32x4*)(sout + i * HV) = (f32x4){S[i][0], S[i][1], S[i][2], S[i][3]};
}
__device__ __forceinline__ void p5_scan(const Args& A, LAS unsigned char* lds) {
    constexpr int N_SSD_P = NBP * SH, N_GLA_P = NBP * HH, N_SSD_S = NBS * SH, N_GLA_S = NBS * HH;
    constexpr int NIT = N_SSD_P + N_GLA_P + N_SSD_S + N_GLA_S;
    volatile LAS int* slot = (volatile LAS int*)(lds + MISC_OFF + 64);
    unsigned* qctr = (unsigned*)(A.ws + WS_CTL) + CW_Q;
    for (;;) {
        __syncthreads();
        if (threadIdx.x == 0) *slot = (int)__hip_atomic_fetch_add(qctr, 1u, __ATOMIC_RELAXED, __HIP_MEMORY_SCOPE_AGENT);
        __syncthreads();
        const int it = __builtin_amdgcn_readfirstlane(*slot);
        if (it >= NIT) break;
        int r = it;
        if (r < N_GLA_P) { gla_chain(A, lds, r / HH, r % HH); continue; } r -= N_GLA_P;
        if (r < N_SSD_P) { ssd_chain(A, lds, r / SH, r % SH); continue; } r -= N_SSD_P;
        if (r < N_SSD_S) { ssd_item(A, lds, NBP + r / SH, r % SH); continue; } r -= N_SSD_S;
        gla_item(A, lds, NBP + r / HH, r % HH);
    }
}
__device__ __forceinline__ void p6_norm(const Args& A, int vcu, int G) {
    const int tid = tid_op(), lane = tid & 63, wave = __builtin_amdgcn_readfirstlane(tid >> 6), gw = vcu * NWAVES + wave, NGW = G * NWAVES;
    unsigned char* ws = A.ws; bf16* MIX = (bf16*)(ws + WS_MIX); const bf16* OGS = (const bf16*)(ws + WS_OGS); const bf16* ZS = (const bf16*)(ws + WS_ZS);
    for (int m = gw; m < MT; m += NGW) {
#pragma unroll
        for (int j = 0; j < 4; ++j) {
            const int c = (j * 64 + lane) * 8;
            float f[8]; unpack8(*(const GAS v4u*)(MIX + (size_t)m * 2048 + c), f);
            float gv[8]; unpack8(*(const GAS v4u*)((j < 2 ? ZS : OGS) + (size_t)m * DM + (c & 1023)), gv);
            if (j < 2) {
                float sq = 0.f;
#pragma unroll
                for (int i = 0; i < 8; ++i) { f[i] *= gv[i]; sq += f[i] * f[i]; }
                sq = wave_sum(sq);
                const float r = rsqrtf(sq * (1.0f / 512.0f) + EPS);
#pragma unroll
                for (int i = 0; i < 8; ++i) f[i] *= r;
            } else {
                float sq = 0.f;
#pragma unroll
                for (int i = 0; i < 8; ++i) sq += f[i] * f[i];
                sq += __shfl_xor(sq, 1); sq += __shfl_xor(sq, 2); sq += __shfl_xor(sq, 4); sq += __shfl_xor(sq, 8);
                const float r = rsqrtf(sq * (1.0f / 128.0f) + EPS);
#pragma unroll
                for (int i = 0; i < 8; ++i) f[i] *= r * gv[i];
            }
            *(GAS v4u*)(MIX + (size_t)m * 2048 + c) = pack8(f);
        }
    }
}
__device__ __forceinline__ void p12_final(const Args& A, int vcu, int G) {
    const int tid = tid_op(), lane = tid & 63, wave = __builtin_amdgcn_readfirstlane(tid >> 6), gw = vcu * NWAVES + wave, NGW = G * NWAVES;
    const float* stats = (const float*)(A.ws + WS_STATS); const float* nf = A.in[28];
    for (int m = gw; m < MT; m += NGW) {
        const float r = rsqrtf(stats[ST_SS4 + m] * (1.0f / DM) + EPS);
        GAS f32x4* yr = (GAS f32x4*)(A.out + O_Y + (size_t)m * DM) + lane;
#pragma unroll
        for (int j = 0; j < 4; ++j) { const f32x4 w = ((const GAS f32x4*)nf)[lane + 64 * j]; f32x4 v = yr[64 * j]; v = v * r * w; yr[64 * j] = v; }
    }
}

#ifndef MK_N_LAUNCHES
#define MK_N_LAUNCHES 1
#endif
constexpr int N_PHASES = 13;
__global__ void __launch_bounds__(NTHR, 2) mega(Args A) {
    extern __shared__ __attribute__((aligned(16))) unsigned char lds_raw[];
    LAS unsigned char* lds = (LAS unsigned char*)lds_raw;
    for (int u = threadIdx.x; u < (LDS_BYTES - LDSCTL_OFF) / 4; u += NTHR) ((LAS unsigned*)(lds + LDSCTL_OFF))[u] = 0u;
    __syncthreads();
    if (A.ph_hi - A.ph_lo > 1) (void)xcd_barrier_post((unsigned*)(A.ws + WS_CTL) + CW_BAR, (volatile LAS unsigned*)(lds + MISC_OFF) + 8);
    for (int ph = A.ph_lo; ph < A.ph_hi; ++ph) {
        const int G = gridDim.x, bx = blockIdx.x;
        const int vcu = (G % 8 == 0) ? (bx % 8) * (G / 8) + bx / 8 : bx;
        if (ph == 0) p0_prologue(A, lds, vcu, G);
        else if (ph == 4) p4_conv(A, vcu, G);
        else if (ph == 5) p5_scan(A, lds);
        else if (ph == 6) p6_norm(A, vcu, G);
        else if (ph == 12) p12_final(A, vcu, G);
        else {
            unsigned char* ws = A.ws;
            const bf16* Ap; const bf16* Bp; int N, K;
            if (ph == pg8::PH_UP1)      { Ap = (const bf16*)(ws + WS_XB);  Bp = (const bf16*)(ws + WS_W1U);  N = 2 * DFF; K = DM; }
            else if (ph == pg8::PH_DN1) { Ap = (const bf16*)(ws + WS_ACT); Bp = (const bf16*)(ws + WS_W1D);  N = DM;      K = DFF; }
            else if (ph == pg8::PH_IN)  { Ap = (const bf16*)(ws + WS_XB);  Bp = (const bf16*)(ws + WS_WIN);  N = DINP;    K = DM; }
            else if (ph == pg8::PH_OUT) { Ap = (const bf16*)(ws + WS_MIX); Bp = (const bf16*)(ws + WS_WOUT); N = DM;      K = 2048; }
            else if (ph == pg8::PH_UP2) { Ap = (const bf16*)(ws + WS_XB);  Bp = (const bf16*)(ws + WS_W2U);  N = 2 * DFF; K = DM; }
            else if (ph == pg8::PH_DN2) { Ap = (const bf16*)(ws + WS_ACT); Bp = (const bf16*)(ws + WS_W2D);  N = DM;      K = DFF; }
            else if (ph == pg8::PH_PLE) { Ap = (const bf16*)(ws + WS_PB);  Bp = (const bf16*)(ws + WS_WP);   N = DM;      K = PLE; }
            else                        { Ap = (const bf16*)(ws + WS_XB);  Bp = (const bf16*)(ws + WS_WG);   N = DM;      K = DM; }
            pg8::Gemm g{Ap, Bp, MT, N, K}; pg8::StaticOrder S; S.init(MT, N, G, bx);
            pg8::EpiAny E{ws, A.out, A.in[0], A.in[1], ph};
            pg8::gemm_phase<pg8::EpiAny, pg8::StaticOrder, true, true>(lds, g, S, E);
        }
        if (ph + 1 < A.ph_hi) { XcdBarrier b_; b_.bar = (unsigned*)(A.ws + WS_CTL) + CW_BAR; b_.x = xb_xcc_id(); b_.st = (volatile LAS unsigned*)(lds + MISC_OFF) + 8; xcd_barrier(b_); }
    }
}

extern "C" void kernel_launch(void* const* d_in, const int* in_sizes, int n_in, void* d_out, int out_size, void* d_ws, size_t ws_size, hipStream_t stream) {
    static int grid = 0;
    if (grid == 0) {
        if (n_in != 29 || out_size != (int)O_END || ws_size < WS_END) { fprintf(stderr, "kernel_launch: unexpected problem (n_in %d, out %d, ws %zu)\n", n_in, out_size, ws_size); grid = -1; return; }
        int dev = 0, cus = 0;
        if (hipGetDevice(&dev) != hipSuccess || hipDeviceGetAttribute(&cus, hipDeviceAttributeMultiprocessorCount, dev) != hipSuccess) { grid = -1; return; }
        if (hipFuncSetAttribute((const void*)mega, hipFuncAttributeMaxDynamicSharedMemorySize, LDS_BYTES) != hipSuccess) { fprintf(stderr, "kernel_launch: hipFuncSetAttribute failed\n"); grid = -1; return; }
        int per_cu = 0;
        if (hipOccupancyMaxActiveBlocksPerMultiprocessor(&per_cu, (const void*)mega, NTHR, LDS_BYTES) != hipSuccess || per_cu < 1) { fprintf(stderr, "kernel_launch: occupancy query says %d blocks per CU\n", per_cu); grid = -1; return; }
        (void)hipGetLastError();
        grid = cus;
    }
    if (grid < 0) return;
    Args a{};
    for (int i = 0; i < 29; ++i) a.in[i] = (const float*)d_in[i];
    a.out = (float*)d_out; a.ws = (unsigned char*)d_ws;
    if (hipMemsetAsync((char*)d_ws + WS_CTL, 0, CTL_ZERO_BYTES, stream) != hipSuccess) { fprintf(stderr, "kernel_launch: hipMemsetAsync failed\n"); return; }
#if MK_N_LAUNCHES == 1
    a.ph_lo = 0; a.ph_hi = N_PHASES;
    hipLaunchKernelGGL(mega, dim3(grid), dim3(NTHR), LDS_BYTES, stream, a);
#else
    for (int ph = 0; ph < N_PHASES; ++ph) {
        a.ph_lo = ph; a.ph_hi = ph + 1;
        hipLaunchKernelGGL(mega, dim3(grid), dim3(NTHR), LDS_BYTES, stream, a);
    }
#endif
}
```

```cpp
#include <hip/hip_runtime.h>
#include <hip/hip_cooperative_groups.h>
#include <cstdio>
#include <cstdint>
#define PROBE_PH (-1)
namespace pg8 {
#define PG8_LAS __attribute__((address_space(3)))
typedef unsigned short bf16_t;
typedef short bf16x8 __attribute__((ext_vector_type(8)));
typedef float f32x4 __attribute__((ext_vector_type(4)));
typedef unsigned u32x4 __attribute__((ext_vector_type(4)));
constexpr int BM = 256, BK = 64, HALF = 128, HTB = HALF * BK * 2  , STAGE_BYTES = 8 * HTB, NXCD = 8, WGM = 8;

__host__ __device__ __forceinline__ int lds_byte(int r, int c) { const int st = (r >> 4) * 2 + (c >> 5), rr = r & 15, cc = c & 31, ob = rr * 64 + cc * 2; return st * 1024 + (ob ^ (((ob >> 9) & 1) << 5)); }
__host__ __device__ __forceinline__ void stage_rc(int b, int& R, int& C) { const int st = b / 1024, sb = b % 1024, swz = sb ^ (((sb >> 9) & 1) << 5); R = (st >> 1) * 16 + swz / 64; C = (st & 1) * 32 + (swz % 64) / 2; }
__host__ __device__ __forceinline__ int perm32(int rho) { const int n = rho >> 4, i = rho & 15; return 8 * (i >> 2) + 4 * n + (i & 3); }

struct Unit { int pm, pn; };
struct Gemm { const bf16_t* A; const bf16_t* Bt; int M, N, K; };

struct StaticOrder {
    int nM, nN, nwg, G, c;
    __host__ __device__ void init(int M, int N, int G_, int c_) { nM = M / BM; nN = N / BM; nwg = nM * nN; G = G_; c = c_; }
    __host__ __device__ bool next(int i, Unit& u) const {
        const long L = (long)i * G + c; if (L >= nwg) return false;
        int wgid = (int)L; { const int q = nwg / NXCD, r = nwg % NXCD, xcd = wgid % NXCD, off = wgid / NXCD; wgid = (xcd < r ? xcd * (q + 1) : r * (q + 1) + (xcd - r) * q) + off; }
        const int nig = WGM * nN, gid = wgid / nig, fm = gid * WGM, gsz = (nM - fm) < WGM ? (nM - fm) : WGM;
        u.pm = fm + ((wgid % nig) % gsz); u.pn = (wgid % nig) / gsz; return true;
    }
    __device__ __forceinline__ void a_ready(const Unit&) const {}
    __device__ __forceinline__ void done(const Unit&) const {}
};
__device__ __forceinline__ unsigned cvt_pk_bf16(float lo, float hi) { unsigned r; asm volatile("v_cvt_pk_bf16_f32 %0, %1, %2" : "=v"(r) : "v"(lo), "v"(hi)); return r; }
typedef float f32x2 __attribute__((ext_vector_type(2)));
template <class Epi, class Sched, bool ALIGN_EPI = false, bool SP2 = false>
__device__ __forceinline__ void gemm_phase(PG8_LAS unsigned char* lds, const Gemm g, const Sched& S, const Epi& E) {
    const int tid = threadIdx.x, wid = __builtin_amdgcn_readfirstlane(tid >> 6), lane = tid & 63, wr = wid >> 2, wc = wid & 3, fr = lane & 15, fq = lane >> 4;
    const int K = g.K, nt = K / BK;
    unsigned voffA[2], voffB[2];
#pragma unroll
    for (int i = 0; i < 2; ++i) { int R, C; stage_rc(tid * 16 + i * 8192, R, C); const int Rb = Epi::PERM ? ((R & ~31) + perm32(R & 31)) : R;
        voffA[i] = (unsigned)(R * K + C) * 2u; voffB[i] = (unsigned)(Rb * K + C) * 2u; }
    const size_t kstep = (size_t)(BK * 2);
    const size_t hstep = (size_t)HALF * K * 2;
    const size_t tstep = 2 * hstep;
    const unsigned ldsw = (unsigned)wid * 1024u;
    const int aoff = lds_byte(wr * 64 + fr, fq * 8), boff = lds_byte(wc * 32 + fr, fq * 8);
#define PG8_SA(b, h) (((b) * 2 + (h)) * HTB)
#define PG8_SB(b, h) ((4 + (b) * 2 + (h)) * HTB)
#define PG8_STAGE(bufoff, gbase, voff) do { _Pragma("unroll") for (int _i = 0; _i < 2; ++_i) \
        __builtin_amdgcn_global_load_lds((const unsigned*)((const char*)(gbase) + (voff)[_i]), (PG8_LAS unsigned*)(lds + (bufoff) + ldsw + _i * 8192), 16, 0, 0); } while (0)
#define PG8_LDA(dst, b, h) do { _Pragma("unroll") for (int m = 0; m < 4; ++m) _Pragma("unroll") for (int k = 0; k < 2; ++k) dst[m][k] = *(const PG8_LAS bf16x8*)(lds + PG8_SA(b, h) + aoff + m * 2048 + k * 1024); } while (0)
#define PG8_LDB(dst, b, h) do { _Pragma("unroll") for (int n = 0; n < 2; ++n) _Pragma("unroll") for (int k = 0; k < 2; ++k) dst[n][k] = *(const PG8_LAS bf16x8*)(lds + PG8_SB(b, h) + boff + n * 2048 + k * 1024); } while (0)
#define PG8_MMA(ai, bj, At, Bt) do { __builtin_amdgcn_s_setprio(1); _Pragma("unroll") for (int m = 0; m < 4; ++m) _Pragma("unroll") for (int n = 0; n < 2; ++n) _Pragma("unroll") for (int k = 0; k < 2; ++k) \
        acc[ai][bj][m][n] = __builtin_amdgcn_mfma_f32_16x16x32_bf16(Bt[n][k], At[m][k], acc[ai][bj][m][n], 0, 0, 0); __builtin_amdgcn_s_setprio(0); } while (0)
#define PG8_WAIT_V(n) asm volatile("s_waitcnt vmcnt(" #n ")" ::: "memory")
#define PG8_WAIT_L(n) asm volatile("s_waitcnt lgkmcnt(" #n ")" ::: "memory")
#define PG8_BAR __builtin_amdgcn_s_barrier()
#define PG8_SCHED __builtin_amdgcn_sched_barrier(0)
    Unit cur, nxt; int ui = 0;
    if (!S.next(0, cur)) return;
    f32x4 acc[2][2][4][2];
#pragma unroll
    for (int a = 0; a < 2; ++a)
#pragma unroll
        for (int b = 0; b < 2; ++b)
#pragma unroll
            for (int m = 0; m < 4; ++m)
#pragma unroll
                for (int n = 0; n < 2; ++n) acc[a][b][m][n] = (f32x4){0.f, 0.f, 0.f, 0.f};
    bf16x8 At[4][2], B0[2][2], B1[2][2];
    const char* cA = (const char*)g.A + (size_t)cur.pm * tstep; const char* cB = (const char*)g.Bt + (size_t)cur.pn * tstep;
    S.a_ready(cur);
    if constexpr (SP2) {
        PG8_STAGE(PG8_SB(0, 0), cB, voffB); PG8_STAGE(PG8_SB(0, 1), cB + hstep, voffB); PG8_STAGE(PG8_SA(0, 0), cA, voffA); PG8_STAGE(PG8_SA(0, 1), cA + hstep, voffA);
        if (wr == 1) PG8_BAR;
        PG8_WAIT_V(2); PG8_BAR;
        PG8_STAGE(PG8_SB(1, 0), cB + kstep, voffB); PG8_STAGE(PG8_SA(1, 0), cA + kstep, voffA); PG8_STAGE(PG8_SB(1, 1), cB + hstep + kstep, voffB);
        PG8_WAIT_V(6); PG8_BAR;
    } else {
        PG8_STAGE(PG8_SB(0, 0), cB, voffB); PG8_STAGE(PG8_SA(0, 0), cA, voffA); PG8_STAGE(PG8_SB(0, 1), cB + hstep, voffB); PG8_STAGE(PG8_SA(0, 1), cA + hstep, voffA);
        if (wr == 1) PG8_BAR;
        PG8_WAIT_V(4); PG8_BAR;
        PG8_STAGE(PG8_SB(1, 0), cB + kstep, voffB); PG8_STAGE(PG8_SA(1, 0), cA + kstep, voffA); PG8_STAGE(PG8_SB(1, 1), cB + hstep + kstep, voffB);
        PG8_WAIT_V(6); PG8_BAR;
    }
    for (;;) {
        const bool has_next = S.next(ui + 1, nxt);
        const char* nA = has_next ? (const char*)g.A + (size_t)nxt.pm * tstep : cA; const char* nB = has_next ? (const char*)g.Bt + (size_t)nxt.pn * tstep : cB;
        for (int t = 0; t < nt; t += 2) {
            const bool last = (t == nt - 2);
            const char* a1 = cA + (size_t)(t + 1) * kstep;
            const char* a2 = last ? nA : cA + (size_t)(t + 2) * kstep; const char* b2 = last ? nB : cB + (size_t)(t + 2) * kstep;
            const char* a3 = a2 + kstep; const char* b3 = b2 + kstep;
            if (last && has_next) S.a_ready(nxt);
            if constexpr (SP2) {
            PG8_LDB(B0, 0, 0); PG8_LDB(B1, 0, 1); PG8_SCHED; PG8_LDA(At, 0, 0); PG8_STAGE(PG8_SA(1, 1), a1 + hstep, voffA);
            PG8_WAIT_V(8); PG8_WAIT_L(0); PG8_BAR; PG8_MMA(0, 0, At, B0); PG8_MMA(0, 1, At, B1); PG8_BAR; PG8_SCHED;
            PG8_LDA(At, 0, 1); PG8_STAGE(PG8_SB(0, 0), b2, voffB); PG8_STAGE(PG8_SB(0, 1), b2 + hstep, voffB); PG8_STAGE(PG8_SA(0, 0), a2, voffA);
            PG8_WAIT_V(8); PG8_WAIT_L(0); PG8_BAR; PG8_MMA(1, 0, At, B0); PG8_MMA(1, 1, At, B1); PG8_BAR; PG8_SCHED;
            PG8_LDB(B0, 1, 0); PG8_LDB(B1, 1, 1); PG8_SCHED; PG8_LDA(At, 1, 0); PG8_STAGE(PG8_SA(0, 1), a2 + hstep, voffA);
            PG8_WAIT_V(8); PG8_WAIT_L(0); PG8_BAR; PG8_MMA(0, 0, At, B0); PG8_MMA(0, 1, At, B1); PG8_BAR; PG8_SCHED;
            PG8_LDA(At, 1, 1); PG8_STAGE(PG8_SB(1, 0), b3, voffB); PG8_STAGE(PG8_SB(1, 1), b3 + hstep, voffB); PG8_STAGE(PG8_SA(1, 0), a3, voffA);
            PG8_WAIT_V(8); PG8_WAIT_L(0); PG8_BAR; PG8_MMA(1, 0, At, B0); PG8_MMA(1, 1, At, B1); PG8_BAR; PG8_SCHED;
            } else {
            PG8_LDB(B0, 0, 0); PG8_SCHED; PG8_LDA(At, 0, 0); PG8_STAGE(PG8_SA(1, 1), a1 + hstep, voffA);
            PG8_WAIT_L(8); PG8_BAR; PG8_WAIT_L(0); PG8_MMA(0, 0, At, B0); PG8_BAR; PG8_SCHED;
            PG8_LDB(B1, 0, 1); PG8_STAGE(PG8_SB(0, 0), b2, voffB);
            PG8_BAR; PG8_WAIT_L(0); PG8_MMA(0, 1, At, B1); PG8_BAR;
            PG8_LDA(At, 0, 1); PG8_STAGE(PG8_SA(0, 0), a2, voffA);
            PG8_BAR; PG8_WAIT_L(0); PG8_MMA(1, 0, At, B0); PG8_BAR; PG8_SCHED;
            PG8_STAGE(PG8_SB(0, 1), b2 + hstep, voffB);
            PG8_WAIT_V(6); PG8_BAR; PG8_MMA(1, 1, At, B1); PG8_BAR;
            PG8_LDB(B0, 1, 0); PG8_SCHED; PG8_LDA(At, 1, 0); PG8_STAGE(PG8_SA(0, 1), a2 + hstep, voffA);
            PG8_WAIT_L(8); PG8_BAR; PG8_WAIT_L(0); PG8_MMA(0, 0, At, B0); PG8_BAR; PG8_SCHED;
            PG8_LDB(B1, 1, 1); PG8_STAGE(PG8_SB(1, 0), b3, voffB);
            PG8_BAR; PG8_WAIT_L(0); PG8_MMA(0, 1, At, B1); PG8_BAR;
            PG8_LDA(At, 1, 1); PG8_STAGE(PG8_SA(1, 0), a3, voffA);
            PG8_BAR; PG8_WAIT_L(0); PG8_MMA(1, 0, At, B0); PG8_BAR; PG8_SCHED;
            PG8_STAGE(PG8_SB(1, 1), b3 + hstep, voffB);
            PG8_WAIT_V(6); PG8_BAR; PG8_MMA(1, 1, At, B1); PG8_BAR;
            }
        }
        if constexpr (ALIGN_EPI) { if (wr == 0) PG8_BAR; }
        if constexpr (!Epi::AFTER_DRAIN) { E(acc, cur, wr, wc, fr, fq); S.done(cur); }
        if (!has_next) break;
#pragma unroll
        for (int a = 0; a < 2; ++a)
#pragma unroll
            for (int b = 0; b < 2; ++b)
#pragma unroll
                for (int m = 0; m < 4; ++m)
#pragma unroll
                    for (int n = 0; n < 2; ++n) acc[a][b][m][n] = (f32x4){0.f, 0.f, 0.f, 0.f};
        cur = nxt; cA = nA; cB = nB; ++ui;
        if constexpr (ALIGN_EPI) { if (wr == 1) PG8_BAR; }
    }
    PG8_WAIT_V(0);
    if constexpr (!ALIGN_EPI) { if (wr == 0) PG8_BAR; }
    PG8_BAR;
    if constexpr (Epi::AFTER_DRAIN) { E.fused(acc, cur, wr, wc, fr, fq, lds, wid, lane); S.done(cur); }
#undef PG8_SA
#undef PG8_SB
#undef PG8_STAGE
#undef PG8_LDA
#undef PG8_LDB
#undef PG8_MMA
#undef PG8_WAIT_V
#undef PG8_WAIT_L
#undef PG8_BAR
#undef PG8_SCHED
}
}
#define GAS __attribute__((address_space(1)))
#define LAS __attribute__((address_space(3)))
typedef unsigned short bf16;
typedef unsigned v4u __attribute__((ext_vector_type(4)));
typedef float f32x4 __attribute__((ext_vector_type(4)));
typedef short bf16x8 __attribute__((ext_vector_type(8)));
typedef GAS unsigned gu32;
typedef GAS unsigned long long gu64;
#define RLX_AGENT __ATOMIC_RELAXED, __HIP_MEMORY_SCOPE_AGENT
#define LDS_WAIT() asm volatile("s_waitcnt lgkmcnt(0)" ::: "memory")
#define VM_WAIT() asm volatile("s_waitcnt vmcnt(0)" ::: "memory")
__device__ __forceinline__ unsigned long long rt() { return __builtin_amdgcn_s_memrealtime(); }
__device__ __forceinline__ unsigned f2bf(float f) { unsigned u = __builtin_bit_cast(unsigned, f); return (u + 0x7fffu + ((u >> 16) & 1u)) >> 16; }
typedef __bf16 bf16x2_t __attribute__((ext_vector_type(2)));
typedef float f32x2_t __attribute__((ext_vector_type(2)));
__device__ __forceinline__ unsigned pk2(float lo, float hi) { const f32x2_t v = {lo, hi}; const bf16x2_t b = __builtin_convertvector(v, bf16x2_t); return __builtin_bit_cast(unsigned, b); }
#define XB_TMO      128
#define XB_XCNT(j)  (256  + 64 * (j))
#define XB_XSUB(j)  (1280 + 64 * (j))
#define XB_XGEN(j)  (2304 + 64 * (j))
#define XB_TOP      3328
#define XB_TOPGEN   3392
#define XCD_BAR_WORDS 3456
#define XB_SPIN_CAP (1u << 18)

__device__ __forceinline__ unsigned xb_ld(unsigned* p)              { return __hip_atomic_load(p, __ATOMIC_RELAXED, __HIP_MEMORY_SCOPE_AGENT); }
__device__ __forceinline__ unsigned xb_add(unsigned* p, unsigned v) { return __hip_atomic_fetch_add(p, v, __ATOMIC_RELAXED, __HIP_MEMORY_SCOPE_AGENT); }
__device__ __forceinline__ unsigned xb_xcc_id() { return (unsigned)__builtin_amdgcn_s_getreg((3 << 11) | 20) & 0xFu; }
#define XB_SPIN(cond, bar) do { unsigned _sp = 0; while (cond) { __builtin_amdgcn_s_sleep(1); \
    if ((++_sp & 255u) == 0u) { if (xb_ld(&(bar)[XB_TMO])) break; if (_sp > XB_SPIN_CAP) { atomicAdd(&(bar)[XB_TMO], 1u); break; } } } } while (0)

struct XcdBarrier {
    unsigned* bar; unsigned x;
    volatile LAS unsigned* st;
};

__device__ __forceinline__ XcdBarrier xcd_barrier_post(unsigned* bar, volatile LAS unsigned* st) {
    XcdBarrier b; b.bar = bar; b.x = xb_xcc_id(); b.st = st;
    if (threadIdx.x == 0) (void)xb_add(&bar[XB_XCNT(b.x)], 1u);
    return b;
}
__device__ __forceinline__ void xcd_barrier_complete(unsigned* bar, unsigned x, unsigned& nloc, unsigned& nx) {
    const unsigned G = gridDim.x * gridDim.y * gridDim.z;
    unsigned sum, cnt, mine, sp = 0u;
    for (;;) {
        sum = 0u; cnt = 0u; mine = 0u;
#pragma unroll
        for (unsigned j = 0; j < 16; ++j) { const unsigned c = xb_ld(&bar[XB_XCNT(j)]); sum += c; cnt += (c > 0u) ? 1u : 0u; mine = (j == x) ? c : mine; }
        if (sum == G) break;
        __builtin_amdgcn_s_sleep(1);
        if ((++sp & 255u) == 0u) { if (xb_ld(&bar[XB_TMO])) break; if (sp > XB_SPIN_CAP) { atomicAdd(&bar[XB_TMO], 1u); break; } }
    }
    nloc = mine > 0u ? mine : 1u; nx = cnt > 0u ? cnt : 1u;
}

__device__ __forceinline__ void xcd_barrier(const XcdBarrier& b) {
    asm volatile("s_waitcnt vmcnt(0)" ::: "memory");
    __syncthreads();
    if (threadIdx.x == 0) {
        unsigned* bar = b.bar;
        __builtin_amdgcn_s_waitcnt(0);
        unsigned nloc = b.st[0], nx = b.st[1];
        if (nloc == 0u) { xcd_barrier_complete(bar, b.x, nloc, nx); b.st[0] = nloc; b.st[1] = nx; }
        const unsigned old = xb_add(&bar[XB_XSUB(b.x)], 1u);
        const unsigned gen = old / nloc;
        if (old + 1u == (gen + 1u) * nloc) {
            __builtin_amdgcn_fence(__ATOMIC_RELEASE, "agent");
            asm volatile("s_waitcnt vmcnt(0)" ::: "memory");
            const unsigned og = xb_add(&bar[XB_TOP], 1u);
            const unsigned tg = og / nx;
            if (og + 1u == (tg + 1u) * nx) xb_add(&bar[XB_TOPGEN], 1u);
            else XB_SPIN(xb_ld(&bar[XB_TOPGEN]) == tg, bar);
            __builtin_amdgcn_fence(__ATOMIC_ACQUIRE, "agent");
            xb_add(&bar[XB_XGEN(b.x)], 1u);
            asm volatile("s_waitcnt vmcnt(0)" ::: "memory");
        } else {
            XB_SPIN(xb_ld(&bar[XB_XGEN(b.x)]) == gen, bar);
            __builtin_amdgcn_fence(__ATOMIC_ACQUIRE, "agent");
            asm volatile("s_waitcnt vmcnt(0)" ::: "memory");
        }
    }
    __syncthreads();
}

constexpr int DM = 1024, NBP = 8, SEQ = 2048, NBS = 128, DSEQ = 4;
constexpr int MP = NBP * SEQ, MS = NBS * DSEQ, MT = MP + MS;
constexpr int PLE = 256, DFF = 2816;
constexpr int SH = 16, SP = 64, SN = 128, CONVD = 1536;
constexpr int HH = 8, HK = 128, HV = 128;
constexpr int DIN = 6672, DINP = 6912;
constexpr float EPS = 1e-6f;
constexpr int NSEQ = NBP + NBS;
constexpr int NWAVES = 8, NTHR = 512;
constexpr size_t O_Y = 0, O_CP = 17301504, O_SP = 17338368, O_HP = 18386944, O_CS = 19435520, O_SS = 20025344, O_HS = 36802560, O_END = 53579776;
constexpr size_t MiB = 1u << 20;
constexpr size_t WS_CTL = 0, CTL_ZERO_BYTES = 1 * MiB;
constexpr size_t WS_STATS = 1 * MiB;
constexpr size_t WS_W1U = 4 * MiB, WS_W1D = 16 * MiB, WS_WIN = 22 * MiB, WS_WOUT = 36 * MiB, WS_W2U = 40 * MiB, WS_W2D = 52 * MiB, WS_WG = 58 * MiB, WS_WP = 60 * MiB;
constexpr size_t WS_XB = 64 * MiB, WS_PB = 98 * MiB, WS_XR = 108 * MiB, WS_ACT = 176 * MiB;
constexpr size_t WS_ZS = 268 * MiB, WS_XBC = 302 * MiB, WS_DT = 352 * MiB, WS_QS = 354 * MiB, WS_LOGF = 388 * MiB, WS_KK = 454 * MiB, WS_VV = 488 * MiB, WS_OGS = 522 * MiB;
constexpr size_t WS_MIX = 556 * MiB, WS_E = 622 * MiB, WS_CONV = 688 * MiB, WS_END = 738 * MiB;
static_assert(WS_W1U + (size_t)5632 * 1024 * 2 <= WS_W1D && WS_W1D + (size_t)1024 * 2816 * 2 <= WS_WIN && WS_WIN + (size_t)DINP * 1024 * 2 <= WS_WOUT && WS_WOUT + (size_t)1024 * 2048 * 2 <= WS_W2U, "ws map (weights)");
static_assert(WS_XB + (size_t)MT * 1024 * 2 <= WS_PB && WS_PB + (size_t)MT * 256 * 2 <= WS_XR && WS_XR + (size_t)MT * 1024 * 4 <= WS_ACT && WS_ACT + (size_t)MT * DFF * 2 <= WS_ZS, "ws map (acts)");
static_assert(WS_ZS + (size_t)MT * 1024 * 2 <= WS_XBC && WS_XBC + (size_t)MT * 1536 * 2 <= WS_DT && WS_DT + (size_t)MT * 16 * 4 <= WS_QS && WS_QS + (size_t)MT * 1024 * 2 <= WS_LOGF && WS_LOGF + (size_t)MT * 1024 * 4 <= WS_KK, "ws map (proj)");
static_assert(WS_MIX + (size_t)MT * 2048 * 2 <= WS_E && WS_E + (size_t)MT * 1024 * 4 <= WS_CONV && WS_CONV + (size_t)MP * 1536 * 2 <= WS_END, "ws map (mix)");
constexpr int ST_SS0 = 0, ST_SS1 = MT, ST_SS2 = 2 * MT, ST_SS3 = 3 * MT, ST_SS4 = 4 * MT, ST_SSE = 5 * MT, ST_SSD = 6 * MT, ST_SHG = 8 * MT, ST_LB = 16 * MT, ST_END = 16 * MT + 1024;
static_assert((size_t)ST_END * 4 <= 3 * MiB, "stats region");
constexpr int CW_BAR = 4096, CW_Q = 64;
constexpr int RING_BYTES = 131072, LDS_BYTES = 163840, LDSCTL_OFF = LDS_BYTES - 1024, MISC_OFF = LDSCTL_OFF + 320;

__device__ __forceinline__ float bf2f(bf16 b) { return __builtin_bit_cast(float, (unsigned)b << 16); }
__device__ __forceinline__ float siluf(float x) { return x / (1.0f + __expf(-x)); }
__device__ __forceinline__ float sigmoidf_(float x) { return 1.0f / (1.0f + __expf(-x)); }
__device__ __forceinline__ float softplusf_(float x) { return fmaxf(x, 0.f) + log1pf(__expf(-fabsf(x))); }
__device__ __forceinline__ int tid_op() { int t = threadIdx.x; asm volatile("" : "+v"(t)); return t; }
__device__ __forceinline__ float wave_sum(float v) {
#pragma unroll
    for (int o = 1; o < 64; o <<= 1) v += __shfl_xor(v, o);
    return v;
}

constexpr int ST_DTB = ST_LB + 1024, ST_POST = ST_DTB + 16;
static_assert((size_t)(ST_POST + 1024) * 4 <= 3 * MiB, "stats region");
namespace pg8 {
typedef const f32x4 (&AccRef)[2][2][4][2];
__device__ __forceinline__ void epi_up(AccRef acc, const Unit& u, int wr, int wc, int fr, int fq, bf16_t* O, const float* ss) {
    const int row0 = u.pm * BM + wr * 64 + fr, col0 = u.pn * 128 + wc * 32 + 8 * fq;
#pragma unroll
    for (int ai = 0; ai < 2; ++ai)
#pragma unroll
        for (int m = 0; m < 4; ++m) {
            const int row = row0 + ai * HALF + m * 16;
            const float rs = rsqrtf(ss[row] * (1.0f / DM) + EPS);
            float a[8];
#pragma unroll
            for (int n = 0; n < 2; ++n)
#pragma unroll
                for (int i = 0; i < 4; ++i) { const float g = acc[ai][0][m][n][i] * rs, uu = acc[ai][1][m][n][i] * rs; a[4 * n + i] = siluf(g) * uu; }
            u32x4 w; w.x = cvt_pk_bf16(a[0], a[1]); w.y = cvt_pk_bf16(a[2], a[3]); w.z = cvt_pk_bf16(a[4], a[5]); w.w = cvt_pk_bf16(a[6], a[7]);
            *(u32x4*)(O + (size_t)row * DFF + col0) = w;
        }
}
__device__ __forceinline__ void epi_res(AccRef acc, const Unit& u, int wr, int wc, int fr, int fq, const float* resP, const float* resS, float* xr, bf16_t* xb, float* ssout, float alpha) {
    const int row0 = u.pm * BM + wr * 64 + fr, col0 = u.pn * BM + wc * 32 + 8 * fq;
#pragma unroll
    for (int ai = 0; ai < 2; ++ai)
#pragma unroll
        for (int m = 0; m < 4; ++m) {
            const int row = row0 + ai * HALF + m * 16;
            const float* rp = (row < MP) ? resP + (size_t)row * DM : resS + (size_t)(row - MP) * DM;
            float sq = 0.f;
#pragma unroll
            for (int bj = 0; bj < 2; ++bj) {
                const int c = col0 + bj * HALF;
                const f32x4 r0 = *(const f32x4*)(rp + c), r1 = *(const f32x4*)(rp + c + 4);
                const f32x4 v0 = r0 + acc[ai][bj][m][0] * alpha, v1 = r1 + acc[ai][bj][m][1] * alpha;
                *(f32x4*)(xr + (size_t)row * DM + c) = v0; *(f32x4*)(xr + (size_t)row * DM + c + 4) = v1;
                u32x4 w; w.x = cvt_pk_bf16(v0[0], v0[1]); w.y = cvt_pk_bf16(v0[2], v0[3]); w.z = cvt_pk_bf16(v1[0], v1[1]); w.w = cvt_pk_bf16(v1[2], v1[3]);
                *(u32x4*)(xb + (size_t)row * DM + c) = w;
                sq += (v0[0] * v0[0] + v0[1] * v0[1]) + (v0[2] * v0[2] + v0[3] * v0[3]) + (v1[0] * v1[0] + v1[1] * v1[1]) + (v1[2] * v1[2] + v1[3] * v1[3]);
            }
            sq += __shfl_xor(sq, 16); sq += __shfl_xor(sq, 32);
            if (fq == 0) atomicAdd(ssout + row, sq);
        }
}
template <int KIND>
__device__ __forceinline__ void epi_in_kind(AccRef acc, int row0, int cbase, int wc, int fq, const float* ss, bf16_t* ob, int ldo, float* of, const float* aux, float* conv_p, float* conv_s) {
#pragma unroll
    for (int ai = 0; ai < 2; ++ai)
#pragma unroll
        for (int m = 0; m < 4; ++m) {
            const int row = row0 + ai * HALF + m * 16;
            const float rs = rsqrtf(ss[row] * (1.0f / DM) + EPS);
#pragma unroll
            for (int bj = 0; bj < 2; ++bj) {
                float v[8];
#pragma unroll
                for (int n = 0; n < 2; ++n)
#pragma unroll
                    for (int i = 0; i < 4; ++i) v[4 * n + i] = acc[ai][bj][m][n][i] * rs;
                const int ct = bj * HALF + wc * 32 + 8 * fq, c = cbase + ct;
                if (KIND == 0) {
                    u32x4 w; w.x = cvt_pk_bf16(siluf(v[0]), siluf(v[1])); w.y = cvt_pk_bf16(siluf(v[2]), siluf(v[3])); w.z = cvt_pk_bf16(siluf(v[4]), siluf(v[5])); w.w = cvt_pk_bf16(siluf(v[6]), siluf(v[7]));
                    *(u32x4*)(ob + (size_t)row * ldo + c) = w;
                } else if (KIND == 1 || KIND == 2) {
                    u32x4 w; w.x = cvt_pk_bf16(v[0], v[1]); w.y = cvt_pk_bf16(v[2], v[3]); w.z = cvt_pk_bf16(v[4], v[5]); w.w = cvt_pk_bf16(v[6], v[7]);
                    *(u32x4*)(ob + (size_t)row * ldo + c) = w;
                    if (KIND == 2) {
                        float* dst = nullptr;
                        if (row < MP) { const int t = row & (SEQ - 1); if (t >= SEQ - 3) dst = conv_p + ((size_t)(row >> 11) * 3 + (t - (SEQ - 3))) * CONVD + c; }
                        else { const int t = row & 3; if (t >= 1) dst = conv_s + ((size_t)((row - MP) >> 2) * 3 + (t - 1)) * CONVD + c; }
                        if (dst) { *(f32x4*)dst = (f32x4){v[0], v[1], v[2], v[3]}; *(f32x4*)(dst + 4) = (f32x4){v[4], v[5], v[6], v[7]}; }
                    }
                } else if (KIND == 3) {
                    const f32x4 l0 = *(const f32x4*)(aux + c), l1 = *(const f32x4*)(aux + c + 4);
                    float lf[8], kv[8];
#pragma unroll
                    for (int i = 0; i < 8; ++i) { const float lbv = i < 4 ? l0[i & 3] : l1[i & 3]; const float f = lbv + (1.0f - lbv) * sigmoidf_(v[i]); lf[i] = __logf(f); kv[i] = 1.0f - f; }
                    *(f32x4*)(of + (size_t)row * DM + c) = (f32x4){lf[0], lf[1], lf[2], lf[3]}; *(f32x4*)(of + (size_t)row * DM + c + 4) = (f32x4){lf[4], lf[5], lf[6], lf[7]};
                    u32x4 w; w.x = cvt_pk_bf16(kv[0], kv[1]); w.y = cvt_pk_bf16(kv[2], kv[3]); w.z = cvt_pk_bf16(kv[4], kv[5]); w.w = cvt_pk_bf16(kv[6], kv[7]);
                    *(u32x4*)(ob + (size_t)row * ldo + c) = w;
                } else {
                    if (ct < 16) {
                        const f32x4 b0 = *(const f32x4*)(aux + ct), b1 = *(const f32x4*)(aux + ct + 4);
                        f32x4 o0, o1;
#pragma unroll
                        for (int i = 0; i < 4; ++i) { o0[i] = softplusf_(v[i] + b0[i]); o1[i] = softplusf_(v[4 + i] + b1[i]); }
                        *(f32x4*)(of + (size_t)row * 16 + ct) = o0; *(f32x4*)(of + (size_t)row * 16 + ct + 4) = o1;
                    }
                }
            }
        }
}
__device__ __forceinline__ void epi_e(AccRef acc, const Unit& u, int wr, int wc, int fr, int fq, float* E, float* sse) {
    const int row0 = u.pm * BM + wr * 64 + fr, col0 = u.pn * BM + wc * 32 + 8 * fq;
#pragma unroll
    for (int ai = 0; ai < 2; ++ai)
#pragma unroll
        for (int m = 0; m < 4; ++m) {
            const int row = row0 + ai * HALF + m * 16; float sq = 0.f;
#pragma unroll
            for (int bj = 0; bj < 2; ++bj) {
                const int c = col0 + bj * HALF; const f32x4 v0 = acc[ai][bj][m][0], v1 = acc[ai][bj][m][1];
                *(f32x4*)(E + (size_t)row * DM + c) = v0; *(f32x4*)(E + (size_t)row * DM + c + 4) = v1;
                sq += (v0[0] * v0[0] + v0[1] * v0[1]) + (v0[2] * v0[2] + v0[3] * v0[3]) + (v1[0] * v1[0] + v1[1] * v1[1]) + (v1[2] * v1[2] + v1[3] * v1[3]);
            }
            sq += __shfl_xor(sq, 16); sq += __shfl_xor(sq, 32);
            if (fq == 0) atomicAdd(sse + row, sq);
        }
}
__device__ __forceinline__ void epi_gate(AccRef acc, const Unit& u, int wr, int wc, int fr, int fq, const float* ss3, const float* E, const float* sse, const float* post, const float* xr, float* y, float* ss4) {
    const int row0 = u.pm * BM + wr * 64 + fr, col0 = u.pn * BM + wc * 32 + 8 * fq;
#pragma unroll
    for (int ai = 0; ai < 2; ++ai)
#pragma unroll
        for (int m = 0; m < 4; ++m) {
            const int row = row0 + ai * HALF + m * 16; float sq = 0.f;
            const float rs = rsqrtf(ss3[row] * (1.0f / DM) + EPS), re = rsqrtf(sse[row] * (1.0f / DM) + EPS);
#pragma unroll
            for (int bj = 0; bj < 2; ++bj) {
                const int c = col0 + bj * HALF;
#pragma unroll
                for (int n = 0; n < 2; ++n) {
                    const f32x4 e = *(const f32x4*)(E + (size_t)row * DM + c + 4 * n), pw = *(const f32x4*)(post + c + 4 * n), x = *(const f32x4*)(xr + (size_t)row * DM + c + 4 * n);
                    f32x4 o;
#pragma unroll
                    for (int i = 0; i < 4; ++i) { o[i] = x[i] + sigmoidf_(acc[ai][bj][m][n][i] * rs) * (e[i] * re * pw[i]); sq += o[i] * o[i]; }
                    *(f32x4*)(y + (size_t)row * DM + c + 4 * n) = o;
                }
            }
            sq += __shfl_xor(sq, 16); sq += __shfl_xor(sq, 32);
            if (fq == 0) atomicAdd(ss4 + row, sq);
        }
}
constexpr int PH_UP1 = 1, PH_DN1 = 2, PH_IN = 3, PH_OUT = 7, PH_UP2 = 8, PH_DN2 = 9, PH_PLE = 10, PH_GATE = 11;
struct EpiAny {
    static constexpr bool PERM = true, AFTER_DRAIN = false;
    unsigned char* ws; float* out; const float* xP; const float* xS; int ph;
    __device__ __forceinline__ void operator()(AccRef acc, const Unit& u, int wr, int wc, int fr_, int fq_) const {
        int lane_ = threadIdx.x & 63; asm volatile("" : "+v"(lane_)); const int fr = lane_ & 15, fq = lane_ >> 4;
        unsigned char* w_ = ws; asm volatile("" : "+s"(w_));
        float* stats = (float*)(w_ + WS_STATS); float* XR = (float*)(w_ + WS_XR); bf16_t* XB = (bf16_t*)(w_ + WS_XB); bf16_t* ACT = (bf16_t*)(w_ + WS_ACT);
        if (ph >= 64) return;
        if (ph == PH_UP1 || ph == PH_UP2) epi_up(acc, u, wr, wc, fr, fq, ACT, stats + (ph == PH_UP1 ? ST_SS0 : ST_SS2));
        else if (ph == PH_DN1) epi_res(acc, u, wr, wc, fr, fq, xP, xS, XR, XB, stats + ST_SS1, 0.5f);
        else if (ph == PH_OUT) epi_res(acc, u, wr, wc, fr, fq, XR, XR + (size_t)MP * DM, XR, XB, stats + ST_SS2, 1.0f);
        else if (ph == PH_DN2) epi_res(acc, u, wr, wc, fr, fq, XR, XR + (size_t)MP * DM, XR, XB, stats + ST_SS3, 0.5f);
        else if (ph == PH_IN) {
            const int row0 = u.pm * BM + wr * 64 + fr, pn = u.pn; const float* ss = stats + ST_SS1;
            if (pn < 4) epi_in_kind<0>(acc, row0, pn * 256, wc, fq, ss, (bf16_t*)(w_ + WS_ZS), DM, nullptr, nullptr, nullptr, nullptr);
            else if (pn < 10) epi_in_kind<2>(acc, row0, (pn - 4) * 256, wc, fq, ss, (bf16_t*)(w_ + WS_XBC), CONVD, nullptr, nullptr, out + O_CP, out + O_CS);
            else if (pn < 14) epi_in_kind<0>(acc, row0, (pn - 10) * 256, wc, fq, ss, (bf16_t*)(w_ + WS_QS), DM, nullptr, nullptr, nullptr, nullptr);
            else if (pn < 18) epi_in_kind<3>(acc, row0, (pn - 14) * 256, wc, fq, ss, (bf16_t*)(w_ + WS_KK), DM, (float*)(w_ + WS_LOGF), stats + ST_LB, nullptr, nullptr);
            else if (pn < 22) epi_in_kind<1>(acc, row0, (pn - 18) * 256, wc, fq, ss, (bf16_t*)(w_ + WS_VV), DM, nullptr, nullptr, nullptr, nullptr);
            else if (pn < 26) epi_in_kind<0>(acc, row0, (pn - 22) * 256, wc, fq, ss, (bf16_t*)(w_ + WS_OGS), DM, nullptr, nullptr, nullptr, nullptr);
            else epi_in_kind<4>(acc, row0, 0, wc, fq, ss, nullptr, 0, (float*)(w_ + WS_DT), stats + ST_DTB, nullptr, nullptr);
        }
        else if (ph == PH_PLE) epi_e(acc, u, wr, wc, fr, fq, (float*)(w_ + WS_E), stats + ST_SSE);
        else epi_gate(acc, u, wr, wc, fr, fq, stats + ST_SS3, (const float*)(w_ + WS_E), stats + ST_SSE, stats + ST_POST, XR, out + O_Y, stats + ST_SS4);
    }
};
}

__device__ __forceinline__ void tr_item(const float* W, int K, int Nsrc, int k0, int c0, int nvalid, bf16* WT, int drow0, const float* ks, LAS float* scr, int lane) {
    const int r = lane >> 3, c4 = lane & 7;
    f32x4 v[8];
#pragma unroll
    for (int i = 0; i < 8; ++i) v[i] = (4 * c4 < nvalid) ? *(const GAS f32x4*)(W + (size_t)(k0 + 8 * i + r) * Nsrc + c0 + 4 * c4) : (f32x4){0.f, 0.f, 0.f, 0.f};
#pragma unroll
    for (int i = 0; i < 8; ++i) { const float sc = ks ? ks[8 * i + r] : 1.0f; LAS float* d = scr + (8 * i + r) * 33 + 4 * c4;
        d[0] = v[i].x * sc; d[1] = v[i].y * sc; d[2] = v[i].z * sc; d[3] = v[i].w * sc; }
    LDS_WAIT(); asm volatile("" ::: "memory");
    const int c = lane & 7;
#pragma unroll
    for (int j = 0; j < 4; ++j) { const int n = (lane >> 3) + 8 * j; const LAS float* s = scr + (8 * c) * 33 + n;
        v4u o; o.x = pk2(s[0 * 33], s[1 * 33]); o.y = pk2(s[2 * 33], s[3 * 33]); o.z = pk2(s[4 * 33], s[5 * 33]); o.w = pk2(s[6 * 33], s[7 * 33]);
        *(GAS v4u*)(WT + (size_t)(drow0 + n) * K + k0 + 8 * c) = o; }
    LDS_WAIT(); asm volatile("" ::: "memory");
}

struct Args { const float* in[29]; float* out; unsigned char* ws; int ph_lo, ph_hi; };

__device__ __forceinline__ void p0_prologue(const Args& A, LAS unsigned char* lds, int vcu, int G) {
    const int tid = tid_op(), lane = tid & 63, wave = __builtin_amdgcn_readfirstlane(tid >> 6);
    LAS float* scr = (LAS float*)(lds + wave * 16384);
    const int gw = vcu * NWAVES + wave, NGW = G * NWAVES;
    unsigned char* ws = A.ws;
    bf16* W1U = (bf16*)(ws + WS_W1U); bf16* W1D = (bf16*)(ws + WS_W1D); bf16* WIN = (bf16*)(ws + WS_WIN); bf16* WOUT = (bf16*)(ws + WS_WOUT);
    bf16* W2U = (bf16*)(ws + WS_W2U); bf16* W2D = (bf16*)(ws + WS_W2D); bf16* WG = (bf16*)(ws + WS_WG); bf16* WP = (bf16*)(ws + WS_WP);
    constexpr int I_UP = 16 * 176, I_DN = 44 * 32, I_IN = 16 * 216, I_OUT = 32 * 32, I_G = 16 * 32, I_P = 4 * 32;
    constexpr int NITEMS = 2 * I_UP + 2 * I_DN + I_IN + I_OUT + I_G + I_P;
    for (int it = gw; it < NITEMS; it += NGW) {
        int r = it;
        if (r < 2 * I_UP) {
            const int which = r / I_UP; r -= which * I_UP; const int kb = r / 176, nb = r % 176, drow = nb * 32;
            const int t = drow >> 8, rem = drow & 255, h = rem >> 7, i = rem & 127;
            tr_item(which ? A.in[22] : A.in[8], 1024, 2 * DFF, kb * 64, h * DFF + t * 128 + i, 32, which ? W2U : W1U, drow, (which ? A.in[21] : A.in[7]) + kb * 64, scr, lane); continue; }
        r -= 2 * I_UP;
        if (r < 2 * I_DN) { const int which = r / I_DN; r -= which * I_DN; const int kb = r / 32, nb = r % 32;
            tr_item(which ? A.in[23] : A.in[9], DFF, 1024, kb * 64, nb * 32, 32, which ? W2D : W1D, nb * 32, nullptr, scr, lane); continue; }
        r -= 2 * I_DN;
        if (r < I_IN) { const int kb = r / 216, nb = r % 216, drow = nb * 32; int c0, nv = 32;
            if (drow < 2560) c0 = drow; else if (drow < 6656) c0 = drow + 16; else if (drow == 6656) { c0 = 2560; nv = 16; } else { c0 = 0; nv = 0; }
            tr_item(A.in[11], 1024, DIN, kb * 64, c0, nv, WIN, drow, A.in[10] + kb * 64, scr, lane); continue; }
        r -= I_IN;
        if (r < I_OUT) { const int kb = r / 32, nb = r % 32, k0 = kb * 64;
            tr_item(A.in[20], 2048, 1024, k0, nb * 32, 32, WOUT, nb * 32, k0 < 1024 ? A.in[17] + k0 : A.in[19] + (k0 - 1024), scr, lane); continue; }
        r -= I_OUT;
        if (r < I_G) { const int kb = r / 32, nb = r % 32;
            tr_item(A.in[25], 1024, 1024, kb * 64, nb * 32, 32, WG, nb * 32, A.in[24] + kb * 64, scr, lane); continue; }
        r -= I_G;
        { const int kb = r / 32, nb = r % 32; tr_item(A.in[26], PLE, 1024, kb * 64, nb * 32, 32, WP, nb * 32, nullptr, scr, lane); }
    }
    float* stats = (float*)(ws + WS_STATS);
    bf16* XB = (bf16*)(ws + WS_XB); bf16* PB = (bf16*)(ws + WS_PB);
    for (int m = gw; m < MT; m += NGW) {
        const float* xrow = (m < MP) ? A.in[0] + (size_t)m * DM : A.in[1] + (size_t)(m - MP) * DM;
        const GAS f32x4* xr = (const GAS f32x4*)xrow + lane;
        f32x4 v[4]; float s = 0.f;
#pragma unroll
        for (int j = 0; j < 4; ++j) { v[j] = xr[64 * j]; s += (v[j].x * v[j].x + v[j].y * v[j].y) + (v[j].z * v[j].z + v[j].w * v[j].w); }
        s = wave_sum(s);
        if (lane == 0) stats[ST_SS0 + m] = s;
        GAS unsigned long long* o8 = (GAS unsigned long long*)(XB + (size_t)m * DM) + lane;
#pragma unroll
        for (int j = 0; j < 4; ++j) o8[64 * j] = (unsigned long long)pk2(v[j].x, v[j].y) | ((unsigned long long)pk2(v[j].z, v[j].w) << 32);
        const float* prow = (m < MP) ? A.in[5] + (size_t)m * PLE : A.in[6] + (size_t)(m - MP) * PLE;
        const f32x4 pv = ((const GAS f32x4*)prow)[lane];
        ((GAS unsigned long long*)(PB + (size_t)m * PLE))[lane] = (unsigned long long)pk2(pv.x, pv.y) | ((unsigned long long)pk2(pv.z, pv.w) << 32);
    }
    const int gt = vcu * NTHR + tid, NGT = G * NTHR;
    for (int i = gt; i < 15 * MT; i += NGT) stats[MT + i] = 0.f;
    for (int i = gt; i < 1024; i += NGT) { stats[ST_LB + i] = 1.0f / (1.0f + __expf(A.in[18][1024 + i] - A.in[18][i])); stats[ST_POST + i] = A.in[27][i]; }
    if (gt < 16) stats[ST_DTB + gt] = A.in[14][gt];
}

__device__ __forceinline__ void unpack8(const v4u w, float (&f)[8]) {
    f[0] = bf2f((bf16)(w.x & 0xffff)); f[1] = bf2f((bf16)(w.x >> 16)); f[2] = bf2f((bf16)(w.y & 0xffff)); f[3] = bf2f((bf16)(w.y >> 16));
    f[4] = bf2f((bf16)(w.z & 0xffff)); f[5] = bf2f((bf16)(w.z >> 16)); f[6] = bf2f((bf16)(w.w & 0xffff)); f[7] = bf2f((bf16)(w.w >> 16));
}
__device__ __forceinline__ v4u pack8(const float (&f)[8]) { v4u o; o.x = pk2(f[0], f[1]); o.y = pk2(f[2], f[3]); o.z = pk2(f[4], f[5]); o.w = pk2(f[6], f[7]); return o; }
__device__ __forceinline__ void p4_conv(const Args& A, int vcu, int G) {
    const int tid = tid_op(), gt = vcu * NTHR + tid, NGT = G * NTHR;
    const bf16* XBC = (const bf16*)(A.ws + WS_XBC); bf16* CONV = (bf16*)(A.ws + WS_CONV);
    const float* conv_w = A.in[12]; const float* conv_b = A.in[13];
    constexpr int NCG = CONVD / 8, NSTRIP = MP / 8;
    for (int u = gt; u < NSTRIP * NCG; u += NGT) {
        const int cg = u % NCG, strip = u / NCG, r0 = strip * 8, tseq = r0 & (SEQ - 1), c = cg * 8;
        float wgt[4][8], bias[8];
#pragma unroll
        for (int j = 0; j < 4; ++j) { const f32x4 a = *(const f32x4*)(conv_w + j * CONVD + c), b = *(const f32x4*)(conv_w + j * CONVD + c + 4);
            wgt[j][0] = a.x; wgt[j][1] = a.y; wgt[j][2] = a.z; wgt[j][3] = a.w; wgt[j][4] = b.x; wgt[j][5] = b.y; wgt[j][6] = b.z; wgt[j][7] = b.w; }
        { const f32x4 a = *(const f32x4*)(conv_b + c), b = *(const f32x4*)(conv_b + c + 4); bias[0] = a.x; bias[1] = a.y; bias[2] = a.z; bias[3] = a.w; bias[4] = b.x; bias[5] = b.y; bias[6] = b.z; bias[7] = b.w; }
        v4u raw[11];
#pragma unroll
        for (int i = 0; i < 11; ++i) { const bool ok = (tseq - 3 + i) >= 0;
            raw[i] = ok ? *(const GAS v4u*)(XBC + (size_t)(r0 - 3 + i) * CONVD + c) : (v4u){0u, 0u, 0u, 0u}; }
#pragma unroll
        for (int j = 0; j < 8; ++j) {
            float acc[8];
#pragma unroll
            for (int e = 0; e < 8; ++e) acc[e] = bias[e];
#pragma unroll
            for (int jj = 0; jj < 4; ++jj) { float f[8]; unpack8(raw[j + jj], f);
#pragma unroll
                for (int e = 0; e < 8; ++e) acc[e] += wgt[jj][e] * f[e]; }
#pragma unroll
            for (int e = 0; e < 8; ++e) acc[e] = siluf(acc[e]);
            *(GAS v4u*)(CONV + (size_t)(r0 + j) * CONVD + c) = pack8(acc);
        }
    }
}

typedef float f32x16 __attribute__((ext_vector_type(16)));
typedef unsigned u32x2 __attribute__((ext_vector_type(2)));
typedef float f32x2g __attribute__((ext_vector_type(2)));
#define MFMA32(a, b, c) __builtin_amdgcn_mfma_f32_32x32x16_bf16(a, b, c, 0, 0, 0)
#define LDS_FRAG(base, row, k) (*(const LAS bf16x8*)(lds + (base) + (row) * 272 + (k) * 2))
#define LDS_FRAG64(base, row, k) (*(const LAS bf16x8*)(lds + (base) + (row) * 144 + (k) * 2))
constexpr int SSD_L_CM = 0, SSD_L_BM = 34816, SSD_L_BT = 69632, SSD_L_XT = 104448, SSD_L_HB = 121856, SSD_L_F = 139264;
static_assert(SSD_L_F + 2048 <= LDSCTL_OFF, "SSD chain LDS image vs the control words");
__device__ __forceinline__ void ssd_chain(const Args& A, LAS unsigned char* lds, int b, int h) {
    const int tid = tid_op(), lane = tid & 63, w = __builtin_amdgcn_readfirstlane(tid >> 6), l31 = lane & 31, lh = lane >> 5, g = h >> 3;
    const bf16* CONV = (const bf16*)(A.ws + WS_CONV); const float* DT = (const float*)(A.ws + WS_DT); bf16* MIX = (bf16*)(A.ws + WS_MIX);
    const float a = -__expf(A.in[15][h]), dsk = A.in[16][h];
    LAS float* acs = (LAS float*)(lds + SSD_L_F); LAS float* dtv = acs + 128; LAS float* sc = acs + 256; LAS float* eacs = acs + 384;
    f32x16 hacc;
#pragma unroll
    for (int i = 0; i < 16; ++i) hacc[i] = 0.f;
    v4u pcv[4], pbv[4]; unsigned prB[16], prX[8]; float pd0 = 0.f, pd1 = 0.f;
#define SSD_LOAD(R0) do { \
        _Pragma("unroll") for (int i_ = 0; i_ < 4; ++i_) { const int piece_ = tid + NTHR * i_, row_ = piece_ >> 4, pc_ = piece_ & 15; \
            pcv[i_] = *(const GAS v4u*)(CONV + (size_t)((R0) + row_) * CONVD + 1280 + g * 128 + pc_ * 8); pbv[i_] = *(const GAS v4u*)(CONV + (size_t)((R0) + row_) * CONVD + 1024 + g * 128 + pc_ * 8); } \
        _Pragma("unroll") for (int j_ = 0; j_ < 16; ++j_) prB[j_] = *(const GAS unsigned*)(CONV + (size_t)((R0) + 16 * w + j_) * CONVD + 1024 + g * 128 + 2 * lane); \
        _Pragma("unroll") for (int j_ = 0; j_ < 8; ++j_) prX[j_] = *(const GAS unsigned*)(CONV + (size_t)((R0) + 16 * w + 8 * lh + j_) * CONVD + h * 64 + 2 * l31); \
        if (w == 0) { pd0 = DT[(size_t)((R0) + 2 * lane) * 16 + h]; pd1 = DT[(size_t)((R0) + 2 * lane + 1) * 16 + h]; } } while (0)
    SSD_LOAD(b * SEQ);
    for (int c = 0; c < SEQ / 128; ++c) {
        const int r0 = b * SEQ + c * 128;
        __syncthreads();
#pragma unroll
        for (int i = 0; i < 4; ++i) { const int piece = tid + NTHR * i, row = piece >> 4, pc = piece & 15;
            *(LAS v4u*)(lds + SSD_L_CM + row * 272 + pc * 16) = pcv[i]; *(LAS v4u*)(lds + SSD_L_BM + row * 272 + pc * 16) = pbv[i]; }
        { v4u lo0, lo1, hi0, hi1; const unsigned (&r)[16] = prB;
            lo0.x = (r[0] & 0xffffu) | (r[1] << 16); lo0.y = (r[2] & 0xffffu) | (r[3] << 16); lo0.z = (r[4] & 0xffffu) | (r[5] << 16); lo0.w = (r[6] & 0xffffu) | (r[7] << 16);
            lo1.x = (r[8] & 0xffffu) | (r[9] << 16); lo1.y = (r[10] & 0xffffu) | (r[11] << 16); lo1.z = (r[12] & 0xffffu) | (r[13] << 16); lo1.w = (r[14] & 0xffffu) | (r[15] << 16);
            hi0.x = (r[0] >> 16) | (r[1] & 0xffff0000u); hi0.y = (r[2] >> 16) | (r[3] & 0xffff0000u); hi0.z = (r[4] >> 16) | (r[5] & 0xffff0000u); hi0.w = (r[6] >> 16) | (r[7] & 0xffff0000u);
            hi1.x = (r[8] >> 16) | (r[9] & 0xffff0000u); hi1.y = (r[10] >> 16) | (r[11] & 0xffff0000u); hi1.z = (r[12] >> 16) | (r[13] & 0xffff0000u); hi1.w = (r[14] >> 16) | (r[15] & 0xffff0000u);
            *(LAS v4u*)(lds + SSD_L_BT + (2 * lane) * 272 + 32 * w) = lo0; *(LAS v4u*)(lds + SSD_L_BT + (2 * lane) * 272 + 32 * w + 16) = lo1;
            *(LAS v4u*)(lds + SSD_L_BT + (2 * lane + 1) * 272 + 32 * w) = hi0; *(LAS v4u*)(lds + SSD_L_BT + (2 * lane + 1) * 272 + 32 * w + 16) = hi1; }
        { v4u lo, hi; const unsigned (&r)[8] = prX;
            lo.x = (r[0] & 0xffffu) | (r[1] << 16); lo.y = (r[2] & 0xffffu) | (r[3] << 16); lo.z = (r[4] & 0xffffu) | (r[5] << 16); lo.w = (r[6] & 0xffffu) | (r[7] << 16);
            hi.x = (r[0] >> 16) | (r[1] & 0xffff0000u); hi.y = (r[2] >> 16) | (r[3] & 0xffff0000u); hi.z = (r[4] >> 16) | (r[5] & 0xffff0000u); hi.w = (r[6] >> 16) | (r[7] & 0xffff0000u);
            *(LAS v4u*)(lds + SSD_L_XT + (2 * l31) * 272 + (16 * w + 8 * lh) * 2) = lo; *(LAS v4u*)(lds + SSD_L_XT + (2 * l31 + 1) * 272 + (16 * w + 8 * lh) * 2) = hi; }
        if (w == 0) {
            const float d0 = pd0, d1 = pd1;
            const float x0 = d0 * a, x1 = d1 * a; float ps = x0 + x1;
#pragma unroll
            for (int o = 1; o < 64; o <<= 1) { const float t = __shfl_up(ps, o); if (lane >= o) ps += t; }
            acs[2 * lane] = ps - x1; acs[2 * lane + 1] = ps; dtv[2 * lane] = d0; dtv[2 * lane + 1] = d1;
        }
        if (c + 1 < SEQ / 128) { SSD_LOAD(r0 + 128); }
        __syncthreads();
        const float acs_last = acs[127];
        if (tid < 128) { sc[tid] = dtv[tid] * __expf(acs_last - acs[tid]); eacs[tid] = __expf(acs[tid]); }
        unsigned wreg[2][8];
#pragma unroll
        for (int ti = 0; ti < 2; ++ti) { const int tile = 2 * w + ti, st = tile >> 2, tt = tile & 3;
            if (st <= tt) {
                f32x16 acc;
#pragma unroll
                for (int i = 0; i < 16; ++i) acc[i] = 0.f;
#pragma unroll
                for (int ks = 0; ks < 8; ++ks) acc = MFMA32(LDS_FRAG(SSD_L_BM, 32 * st + l31, 16 * ks + 8 * lh), LDS_FRAG(SSD_L_CM, 32 * tt + l31, 16 * ks + 8 * lh), acc);
                const int t = 32 * tt + l31; const float at = acs[t];
#pragma unroll
                for (int q = 0; q < 4; ++q) { const int s0 = 32 * st + 8 * q + 4 * lh;
                    const f32x4 as4 = *(const LAS f32x4*)(acs + s0), d4 = *(const LAS f32x4*)(dtv + s0); float v[4];
#pragma unroll
                    for (int j = 0; j < 4; ++j) { const int s = s0 + j; float wv = (s <= t) ? acc[4 * q + j] * __expf(at - as4[j]) * d4[j] : 0.f; if (s == t) wv += dsk; v[j] = wv; }
                    wreg[ti][2 * q] = pk2(v[0], v[1]); wreg[ti][2 * q + 1] = pk2(v[2], v[3]); }
            }
        }
        __syncthreads();
#pragma unroll
        for (int ti = 0; ti < 2; ++ti) { const int tile = 2 * w + ti, st = tile >> 2, tt = tile & 3;
            if (st <= tt) { const int t = 32 * tt + l31;
#pragma unroll
                for (int q = 0; q < 4; ++q) *(LAS u32x2*)(lds + SSD_L_BM + t * 272 + (32 * st + 8 * q + 4 * lh) * 2) = (u32x2){wreg[ti][2 * q], wreg[ti][2 * q + 1]}; } }
        __syncthreads();
        { const int pt = w & 1, tt = w >> 1; f32x16 acc;
#pragma unroll
            for (int i = 0; i < 16; ++i) acc[i] = 0.f;
            if (c > 0) {
#pragma unroll
                for (int ks = 0; ks < 8; ++ks) acc = MFMA32(LDS_FRAG(SSD_L_HB, 32 * pt + l31, 16 * ks + 8 * lh), LDS_FRAG(SSD_L_CM, 32 * tt + l31, 16 * ks + 8 * lh), acc);
                const float e = eacs[32 * tt + l31];
#pragma unroll
                for (int i = 0; i < 16; ++i) acc[i] *= e;
            }
            for (int ks = 0; ks < 2 * (tt + 1); ++ks) acc = MFMA32(LDS_FRAG(SSD_L_XT, 32 * pt + l31, 16 * ks + 8 * lh), LDS_FRAG(SSD_L_BM, 32 * tt + l31, 16 * ks + 8 * lh), acc);
            const size_t row = (size_t)(r0 + 32 * tt + l31);
#pragma unroll
            for (int q = 0; q < 4; ++q) *(GAS u32x2*)(MIX + row * 2048 + h * 64 + 32 * pt + 8 * q + 4 * lh) = (u32x2){pk2(acc[4 * q], acc[4 * q + 1]), pk2(acc[4 * q + 2], acc[4 * q + 3])};
        }
        __syncthreads();
#pragma unroll
        for (int i = 0; i < 2; ++i) { const int piece = tid + NTHR * i, p = piece >> 4, pc = piece & 15;
            LAS v4u* px = (LAS v4u*)(lds + SSD_L_XT + p * 272 + pc * 16); float f[8]; unpack8(*px, f);
            const f32x4 s0 = *(const LAS f32x4*)(sc + 8 * pc), s1 = *(const LAS f32x4*)(sc + 8 * pc + 4);
            f[0] *= s0.x; f[1] *= s0.y; f[2] *= s0.z; f[3] *= s0.w; f[4] *= s1.x; f[5] *= s1.y; f[6] *= s1.z; f[7] *= s1.w;
            *px = pack8(f); }
        __syncthreads();
        { const int nt = w >> 1, pt = w & 1; const float dc = __expf(acs_last);
#pragma unroll
            for (int i = 0; i < 16; ++i) hacc[i] *= dc;
#pragma unroll
            for (int ks = 0; ks < 8; ++ks) hacc = MFMA32(LDS_FRAG(SSD_L_BT, 32 * nt + l31, 16 * ks + 8 * lh), LDS_FRAG(SSD_L_XT, 32 * pt + l31, 16 * ks + 8 * lh), hacc);
#pragma unroll
            for (int q = 0; q < 4; ++q) *(LAS u32x2*)(lds + SSD_L_HB + (32 * pt + l31) * 272 + (32 * nt + 8 * q + 4 * lh) * 2) = (u32x2){pk2(hacc[4 * q], hacc[4 * q + 1]), pk2(hacc[4 * q + 2], hacc[4 * q + 3])};
        }
    }
    { const int nt = w >> 1, pt = w & 1; float* o = A.out + O_SP + ((size_t)(b * SH + h) * SP + 32 * pt + l31) * SN + 32 * nt + 4 * lh;
#pragma unroll
        for (int q = 0; q < 4; ++q) *(f32x4*)(o + 8 * q) = (f32x4){hacc[4 * q], hacc[4 * q + 1], hacc[4 * q + 2], hacc[4 * q + 3]}; }
}
constexpr int GL_QE = 0, GL_KE = 17408, GL_KDT = 34816, GL_VT = 53248, GL_ATT = 71680, GL_SB = 80896, GL_TOT = 115712, GL_DEC = 119808;
__device__ __forceinline__ void gla_chain(const Args& A, LAS unsigned char* lds, int b, int h) {
    const int tid = tid_op(), lane = tid & 63, w = __builtin_amdgcn_readfirstlane(tid >> 6), l31 = lane & 31, lh = lane >> 5;
    const bf16* QS = (const bf16*)(A.ws + WS_QS); const bf16* KK = (const bf16*)(A.ws + WS_KK); const bf16* VV = (const bf16*)(A.ws + WS_VV); const float* LOGF = (const float*)(A.ws + WS_LOGF);
    bf16* MIX = (bf16*)(A.ws + WS_MIX);
    LAS float* tot = (LAS float*)(lds + GL_TOT); LAS float* dec = (LAS float*)(lds + GL_DEC);
    const int kt = w >> 1, vt0 = 2 * (w & 1);
    f32x16 S0, S1;
#pragma unroll
    for (int i = 0; i < 16; ++i) { S0[i] = 0.f; S1[i] = 0.f; }
    float lf0[8], lf1[8]; unsigned qv[8], kv[8], vv[8];
#define GLA_LOAD(R0) do { _Pragma("unroll") for (int j_ = 0; j_ < 8; ++j_) { const size_t off_ = (size_t)((R0) + 8 * w + j_) * DM + h * 128 + 2 * lane; \
            const f32x2g lf_ = *(const GAS f32x2g*)(LOGF + off_); lf0[j_] = lf_.x; lf1[j_] = lf_.y; \
            qv[j_] = *(const GAS unsigned*)(QS + off_); kv[j_] = *(const GAS unsigned*)(KK + off_); vv[j_] = *(const GAS unsigned*)(VV + off_); } } while (0)
    GLA_LOAD(b * SEQ);
    for (int c = 0; c < SEQ / 64; ++c) {
        const int r0 = b * SEQ + c * 64;
        __syncthreads();
#pragma unroll
        for (int j = 1; j < 8; ++j) { lf0[j] += lf0[j - 1]; lf1[j] += lf1[j - 1]; }
        *(LAS f32x2g*)(tot + w * 128 + 2 * lane) = (f32x2g){lf0[7], lf1[7]};
        { v4u lo, hi;
            lo.x = (vv[0] & 0xffffu) | (vv[1] << 16); lo.y = (vv[2] & 0xffffu) | (vv[3] << 16); lo.z = (vv[4] & 0xffffu) | (vv[5] << 16); lo.w = (vv[6] & 0xffffu) | (vv[7] << 16);
            hi.x = (vv[0] >> 16) | (vv[1] & 0xffff0000u); hi.y = (vv[2] >> 16) | (vv[3] & 0xffff0000u); hi.z = (vv[4] >> 16) | (vv[5] & 0xffff0000u); hi.w = (vv[6] >> 16) | (vv[7] & 0xffff0000u);
            *(LAS v4u*)(lds + GL_VT + (2 * lane) * 144 + 16 * w) = lo; *(LAS v4u*)(lds + GL_VT + (2 * lane + 1) * 144 + 16 * w) = hi; }
        __syncthreads();
        float off0 = 0.f, off1 = 0.f, t0s = 0.f, t1s = 0.f;
#pragma unroll
        for (int ww = 0; ww < 8; ++ww) { const f32x2g tv = *(const LAS f32x2g*)(tot + ww * 128 + 2 * lane); if (ww < w) { off0 += tv.x; off1 += tv.y; } t0s += tv.x; t1s += tv.y; }
        if (w == 0) *(LAS f32x2g*)(dec + 2 * lane) = (f32x2g){__expf(t0s), __expf(t1s)};
        { float kd0[8], kd1[8];
#pragma unroll
            for (int j = 0; j < 8; ++j) { const float b0 = off0 + lf0[j], b1 = off1 + lf1[j];
                const float q0 = bf2f((bf16)(qv[j] & 0xffffu)), q1 = bf2f((bf16)(qv[j] >> 16)), k0 = bf2f((bf16)(kv[j] & 0xffffu)), k1 = bf2f((bf16)(kv[j] >> 16));
                *(LAS unsigned*)(lds + GL_QE + (8 * w + j) * 272 + 4 * lane) = pk2(q0 * __expf(b0), q1 * __expf(b1));
                *(LAS unsigned*)(lds + GL_KE + (8 * w + j) * 272 + 4 * lane) = pk2(k0 * __expf(-b0), k1 * __expf(-b1));
                kd0[j] = k0 * __expf(t0s - b0); kd1[j] = k1 * __expf(t1s - b1); }
            *(LAS v4u*)(lds + GL_KDT + (2 * lane) * 144 + 16 * w) = pack8(kd0); *(LAS v4u*)(lds + GL_KDT + (2 * lane + 1) * 144 + 16 * w) = pack8(kd1); }
        if (c + 1 < SEQ / 64) { GLA_LOAD(r0 + 64); }
        __syncthreads();
        if (w < 4) { const int st = w >> 1, tt = w & 1;
            if (st <= tt) { f32x16 acc;
#pragma unroll
                for (int i = 0; i < 16; ++i) acc[i] = 0.f;
#pragma unroll
                for (int ks = 0; ks < 8; ++ks) acc = MFMA32(LDS_FRAG(GL_KE, 32 * st + l31, 16 * ks + 8 * lh), LDS_FRAG(GL_QE, 32 * tt + l31, 16 * ks + 8 * lh), acc);
                const int t = 32 * tt + l31;
#pragma unroll
                for (int q = 0; q < 4; ++q) { const int s0 = 32 * st + 8 * q + 4 * lh; float v[4];
#pragma unroll
                    for (int j = 0; j < 4; ++j) v[j] = (s0 + j <= t) ? acc[4 * q + j] : 0.f;
                    *(LAS u32x2*)(lds + GL_ATT + t * 144 + s0 * 2) = (u32x2){pk2(v[0], v[1]), pk2(v[2], v[3])}; } } }
        const int ovt = w >> 1, ott = w & 1; f32x16 oacc;
#pragma unroll
        for (int i = 0; i < 16; ++i) oacc[i] = 0.f;
        if (c > 0) {
#pragma unroll
            for (int ks = 0; ks < 8; ++ks) oacc = MFMA32(LDS_FRAG(GL_SB, 32 * ovt + l31, 16 * ks + 8 * lh), LDS_FRAG(GL_QE, 32 * ott + l31, 16 * ks + 8 * lh), oacc);
        }
        __syncthreads();
        for (int ks = 0; ks < 2 * (ott + 1); ++ks) oacc = MFMA32(LDS_FRAG64(GL_VT, 32 * ovt + l31, 16 * ks + 8 * lh), LDS_FRAG64(GL_ATT, 32 * ott + l31, 16 * ks + 8 * lh), oacc);
        { const size_t row = (size_t)(r0 + 32 * ott + l31);
#pragma unroll
            for (int q = 0; q < 4; ++q) *(GAS u32x2*)(MIX + row * 2048 + 1024 + h * 128 + 32 * ovt + 8 * q + 4 * lh) = (u32x2){pk2(oacc[4 * q], oacc[4 * q + 1]), pk2(oacc[4 * q + 2], oacc[4 * q + 3])}; }
#pragma unroll
        for (int q = 0; q < 4; ++q) { const f32x4 d4 = *(const LAS f32x4*)(dec + 32 * kt + 8 * q + 4 * lh);
#pragma unroll
            for (int j = 0; j < 4; ++j) { S0[4 * q + j] *= d4[j]; S1[4 * q + j] *= d4[j]; } }
#pragma unroll
        for (int ks = 0; ks < 4; ++ks) { const bf16x8 af = LDS_FRAG64(GL_KDT, 32 * kt + l31, 16 * ks + 8 * lh);
            S0 = MFMA32(af, LDS_FRAG64(GL_VT, 32 * vt0 + l31, 16 * ks + 8 * lh), S0); S1 = MFMA32(af, LDS_FRAG64(GL_VT, 32 * (vt0 + 1) + l31, 16 * ks + 8 * lh), S1); }
#pragma unroll
        for (int q = 0; q < 4; ++q) {
            *(LAS u32x2*)(lds + GL_SB + (32 * vt0 + l31) * 272 + (32 * kt + 8 * q + 4 * lh) * 2) = (u32x2){pk2(S0[4 * q], S0[4 * q + 1]), pk2(S0[4 * q + 2], S0[4 * q + 3])};
            *(LAS u32x2*)(lds + GL_SB + (32 * (vt0 + 1) + l31) * 272 + (32 * kt + 8 * q + 4 * lh) * 2) = (u32x2){pk2(S1[4 * q], S1[4 * q + 1]), pk2(S1[4 * q + 2], S1[4 * q + 3])}; }
    }
    { float* o = A.out + O_HP + (size_t)(b * HH + h) * (HK * HV);
#pragma unroll
        for (int q = 0; q < 4; ++q)
#pragma unroll
            for (int j = 0; j < 4; ++j) { const int k = 32 * kt + 8 * q + 4 * lh + j; o[(size_t)k * HV + 32 * vt0 + l31] = S0[4 * q + j]; o[(size_t)k * HV + 32 * (vt0 + 1) + l31] = S1[4 * q + j]; } }
}
__device__ __forceinline__ void ssd_sample(const Args& A, LAS unsigned char* lds, int bs) {
    const int tid = tid_op(), lane = tid & 63, w = __builtin_amdgcn_readfirstlane(tid >> 6), pl = lane >> 3, nq = lane & 7;
    const int rowbase = MP + bs * DSEQ;
    unsigned char* ws = A.ws;
    const bf16* XBC = (const bf16*)(ws + WS_XBC); const float* DT = (const float*)(ws + WS_DT); bf16* MIX = (bf16*)(ws + WS_MIX);
    const float* conv_w = A.in[12]; const float* conv_b = A.in[13]; const float* conv0 = A.in[2] + (size_t)bs * 3 * CONVD;
    LAS float* cv = (LAS float*)lds; LAS float* dts = cv + 4 * CONVD; LAS float* yo = dts + 64;
    __syncthreads();
    for (int idx = tid; idx < 4 * CONVD; idx += NTHR) {
        const int t = idx / CONVD, col = idx - t * CONVD; float av = conv_b[col];
#pragma unroll
        for (int j = 0; j < 4; ++j) { const int tt = t + j - 3;
            const float r = (tt >= 0) ? bf2f(XBC[(size_t)(rowbase + tt) * CONVD + col]) : conv0[(size_t)(3 + tt) * CONVD + col];
            av += conv_w[j * CONVD + col] * r; }
        cv[idx] = siluf(av);
    }
    if (tid < 64) dts[tid] = DT[(size_t)(rowbase + (tid >> 4)) * 16 + (tid & 15)];
    __syncthreads();
    for (int si = w; si < 32; si += NWAVES) {
        const int h = si >> 1, half = si & 1, g = h >> 3;
        const float a = -__expf(A.in[15][h]), dsk = A.in[16][h];
        const float* h0 = A.in[3] + ((size_t)(bs * SH + h) * SP + half * 32 + pl) * SN + nq * 16;
        float* ho = A.out + O_SS + ((size_t)(bs * SH + h) * SP + half * 32 + pl) * SN + nq * 16;
        f32x4 st[4][4];
#pragma unroll
        for (int i = 0; i < 4; ++i)
#pragma unroll
            for (int j = 0; j < 4; ++j) st[i][j] = *(const GAS f32x4*)(h0 + (size_t)(8 * i) * SN + 4 * j);
#pragma unroll
        for (int t = 0; t < 4; ++t) {
            const float dt = dts[t * 16 + h], dA = __expf(dt * a);
            f32x4 B4[4], C4[4];
#pragma unroll
            for (int j = 0; j < 4; ++j) { B4[j] = *(const LAS f32x4*)(cv + t * CONVD + 1024 + g * 128 + nq * 16 + 4 * j); C4[j] = *(const LAS f32x4*)(cv + t * CONVD + 1280 + g * 128 + nq * 16 + 4 * j); }
#pragma unroll
            for (int i = 0; i < 4; ++i) { const int p = half * 32 + 8 * i + pl; const float xv = cv[t * CONVD + h * 64 + p], dx = dt * xv; float y = 0.f;
#pragma unroll
                for (int j = 0; j < 4; ++j) { st[i][j] = st[i][j] * dA + B4[j] * dx; const f32x4 pr = st[i][j] * C4[j]; y += (pr.x + pr.y) + (pr.z + pr.w); }
                y += __shfl_xor(y, 1); y += __shfl_xor(y, 2); y += __shfl_xor(y, 4);
                if (nq == 0) yo[t * 1024 + h * 64 + p] = y + dsk * xv; }
        }
#pragma unroll
        for (int i = 0; i < 4; ++i)
#pragma unroll
            for (int j = 0; j < 4; ++j) *(GAS f32x4*)(ho + (size_t)(8 * i) * SN + 4 * j) = st[i][j];
    }
    __syncthreads();
    { const int idx = tid * 8, t = idx >> 10, c = idx & 1023; float f[8];
#pragma unroll
        for (int e = 0; e < 8; ++e) f[e] = yo[idx + e];
        *(GAS v4u*)(MIX + (size_t)(rowbase + t) * 2048 + c) = pack8(f); }
}
__device__ __forceinline__ void gla_sample(const Args& A, LAS unsigned char* lds, int bs) {
    const int tid = tid_op(), lane = tid & 63, w = __builtin_amdgcn_readfirstlane(tid >> 6), kr = lane >> 5, v4 = 4 * (lane & 31);
    const int rowbase = MP + bs * DSEQ;
    unsigned char* ws = A.ws;
    const bf16* QS = (const bf16*)(ws + WS_QS); const bf16* KK = (const bf16*)(ws + WS_KK); const bf16* VV = (const bf16*)(ws + WS_VV); const float* LOGF = (const float*)(ws + WS_LOGF);
    bf16* MIX = (bf16*)(ws + WS_MIX);
    LAS float* qs = (LAS float*)lds; LAS float* ks = qs + 4096; LAS float* fs = ks + 4096; LAS float* vs = fs + 4096; LAS float* ob = vs + 4096;
    __syncthreads();
    for (int idx = tid; idx < 4096; idx += NTHR) { const size_t o = (size_t)(rowbase + (idx >> 10)) * DM + (idx & 1023);
        qs[idx] = bf2f(QS[o]); ks[idx] = bf2f(KK[o]); fs[idx] = __expf(LOGF[o]); vs[idx] = bf2f(VV[o]); }
    __syncthreads();
    {
        const int h = w;
        const float* s0 = A.in[4] + (size_t)(bs * HH + h) * (HK * HV) + v4;
        float* so = A.out + O_HS + (size_t)(bs * HH + h) * (HK * HV) + v4;
        f32x4 o4[4];
#pragma unroll
        for (int t = 0; t < 4; ++t) o4[t] = (f32x4){0.f, 0.f, 0.f, 0.f};
        for (int qd = 0; qd < 4; ++qd) {
            f32x4 S[16];
#pragma unroll
            for (int i = 0; i < 16; ++i) S[i] = *(const GAS f32x4*)(s0 + (size_t)(qd * 32 + 2 * i + kr) * HV);
#pragma unroll
            for (int t = 0; t < 4; ++t) { const f32x4 vt = *(const LAS f32x4*)(vs + t * 1024 + h * 128 + v4);
#pragma unroll
                for (int i = 0; i < 16; ++i) { const int k = t * 1024 + h * 128 + qd * 32 + 2 * i + kr; const float f = fs[k], kv = ks[k], qv = qs[k];
                    S[i] = S[i] * f + vt * kv; o4[t] += S[i] * qv; } }
#pragma unroll
            for (int i = 0; i < 16; ++i) *(GAS f32x4*)(so + (size_t)(qd * 32 + 2 * i + kr) * HV) = S[i];
        }
#pragma unroll
        for (int t = 0; t < 4; ++t) { f32x4 o = o4[t]; o.x += __shfl_xor(o.x, 32); o.y += __shfl_xor(o.y, 32); o.z += __shfl_xor(o.z, 32); o.w += __shfl_xor(o.w, 32);
            if (lane < 32) *(LAS f32x4*)(ob + t * 1024 + h * 128 + v4) = o; }
    }
    __syncthreads();
    { const int idx = tid * 8, t = idx >> 10, c = idx & 1023; float f[8];
#pragma unroll
        for (int e = 0; e < 8; ++e) f[e] = ob[idx + e];
        *(GAS v4u*)(MIX + (size_t)(rowbase + t) * 2048 + 1024 + c) = pack8(f); }
}
__device__ __forceinline__ void p5_scan(const Args& A, LAS unsigned char* lds, int qword) {
    constexpr int N_SSD_P = NBP * SH, N_GLA_P = NBP * HH;
    constexpr int NIT = N_SSD_P + N_GLA_P + 2 * NBS;
    volatile LAS int* slot = (volatile LAS int*)(lds + MISC_OFF + 64);
    unsigned* qctr = (unsigned*)(A.ws + WS_CTL) + qword;
    for (;;) {
        __syncthreads();
        if (threadIdx.x == 0) *slot = (int)__hip_atomic_fetch_add(qctr, 1u, __ATOMIC_RELAXED, __HIP_MEMORY_SCOPE_AGENT);
        __syncthreads();
        const int it = __builtin_amdgcn_readfirstlane(*slot);
        if (it >= NIT) break;
        int r = it;
        if (r < N_GLA_P) { gla_chain(A, lds, r / HH, r % HH); continue; } r -= N_GLA_P;
        if (r < N_SSD_P) { ssd_chain(A, lds, r / SH, r % SH); continue; } r -= N_SSD_P;
        if (r < NBS) { ssd_sample(A, lds, r); continue; } r -= NBS;
        gla_sample(A, lds, r);
    }
}
__device__ __forceinline__ void p6_norm(const Args& A, int vcu, int G, int dry) {
    const int tid = tid_op(), lane = tid & 63, wave = __builtin_amdgcn_readfirstlane(tid >> 6), gw = vcu * NWAVES + wave, NGW = G * NWAVES;
    unsigned char* ws = A.ws; bf16* MIX = (bf16*)(ws + WS_MIX); const bf16* OGS = (const bf16*)(ws + WS_OGS); const bf16* ZS = (const bf16*)(ws + WS_ZS);
    for (int m = gw; m < MT; m += NGW) {
#pragma unroll
        for (int j = 0; j < 4; ++j) {
            const int c = (j * 64 + lane) * 8;
            float f[8]; unpack8(*(const GAS v4u*)(MIX + (size_t)m * 2048 + c), f);
            float gv[8]; unpack8(*(const GAS v4u*)((j < 2 ? ZS : OGS) + (size_t)m * DM + (c & 1023)), gv);
            if (j < 2) {
                float sq = 0.f;
#pragma unroll
                for (int i = 0; i < 8; ++i) { f[i] *= gv[i]; sq += f[i] * f[i]; }
                sq = wave_sum(sq);
                const float r = rsqrtf(sq * (1.0f / 512.0f) + EPS);
#pragma unroll
                for (int i = 0; i < 8; ++i) f[i] *= r;
            } else {
                float sq = 0.f;
#pragma unroll
                for (int i = 0; i < 8; ++i) sq += f[i] * f[i];
                sq += __shfl_xor(sq, 1); sq += __shfl_xor(sq, 2); sq += __shfl_xor(sq, 4); sq += __shfl_xor(sq, 8);
                const float r = rsqrtf(sq * (1.0f / 128.0f) + EPS);
#pragma unroll
                for (int i = 0; i < 8; ++i) f[i] *= r * gv[i];
            }
            *(GAS v4u*)((dry ? (bf16*)(ws + WS_ACT) : MIX) + (size_t)m * 2048 + c) = pack8(f);
        }
    }
}
__device__ __forceinline__ void p12_final(const Args& A, int vcu, int G, int dry) {
    const int tid = tid_op(), lane = tid & 63, wave = __builtin_amdgcn_readfirstlane(tid >> 6), gw = vcu * NWAVES + wave, NGW = G * NWAVES;
    const float* stats = (const float*)(A.ws + WS_STATS); const float* nf = A.in[28];
    for (int m = gw; m < MT; m += NGW) {
        const float r = rsqrtf(stats[ST_SS4 + m] * (1.0f / DM) + EPS);
        GAS f32x4* yr = (GAS f32x4*)(A.out + O_Y + (size_t)m * DM) + lane; GAS f32x4* yw = dry ? (GAS f32x4*)((float*)(A.ws + WS_ACT) + (size_t)m * DM) + lane : yr;
#pragma unroll
        for (int j = 0; j < 4; ++j) { const f32x4 w = ((const GAS f32x4*)nf)[lane + 64 * j]; f32x4 v = yr[64 * j]; v = v * r * w; yw[64 * j] = v; }
    }
}

#ifndef MK_N_LAUNCHES
#define MK_N_LAUNCHES 1
#endif
constexpr int N_PHASES = 13;
__global__ void __launch_bounds__(NTHR, 2) mega(Args A) {
    extern __shared__ __attribute__((aligned(16))) unsigned char lds_raw[];
    LAS unsigned char* lds = (LAS unsigned char*)lds_raw;
    for (int u = threadIdx.x; u < (LDS_BYTES - LDSCTL_OFF) / 4; u += NTHR) ((LAS unsigned*)(lds + LDSCTL_OFF))[u] = 0u;
    __syncthreads();
    if (A.ph_hi - A.ph_lo > 1) (void)xcd_barrier_post((unsigned*)(A.ws + WS_CTL) + CW_BAR, (volatile LAS unsigned*)(lds + MISC_OFF) + 8);
#ifndef PROBE_PH
#define PROBE_PH (-1)
#endif
    for (int pi = A.ph_lo * 2; pi < A.ph_hi * 2; ++pi) {
        const int ph = pi >> 1, dry = pi & 1;
        if (dry && ph != PROBE_PH) continue;
        const int G = gridDim.x, bx = blockIdx.x;
        const int vcu = (G % 8 == 0) ? (bx % 8) * (G / 8) + bx / 8 : bx;
        if (ph == 0) p0_prologue(A, lds, vcu, G);
        else if (ph == 4) p4_conv(A, vcu, G);
        else if (ph == 5) p5_scan(A, lds, dry ? CW_Q + 64 : CW_Q);
        else if (ph == 6) p6_norm(A, vcu, G, dry);
        else if (ph == 12) p12_final(A, vcu, G, dry);
        else {
            unsigned char* ws = A.ws;
            const bf16* Ap; const bf16* Bp; int N, K;
            if (ph == pg8::PH_UP1)      { Ap = (const bf16*)(ws + WS_XB);  Bp = (const bf16*)(ws + WS_W1U);  N = 2 * DFF; K = DM; }
            else if (ph == pg8::PH_DN1) { Ap = (const bf16*)(ws + WS_ACT); Bp = (const bf16*)(ws + WS_W1D);  N = DM;      K = DFF; }
            else if (ph == pg8::PH_IN)  { Ap = (const bf16*)(ws + WS_XB);  Bp = (const bf16*)(ws + WS_WIN);  N = DINP;    K = DM; }
            else if (ph == pg8::PH_OUT) { Ap = (const bf16*)(ws + WS_MIX); Bp = (const bf16*)(ws + WS_WOUT); N = DM;      K = 2048; }
            else if (ph == pg8::PH_UP2) { Ap = (const bf16*)(ws + WS_XB);  Bp = (const bf16*)(ws + WS_W2U);  N = 2 * DFF; K = DM; }
            else if (ph == pg8::PH_DN2) { Ap = (const bf16*)(ws + WS_ACT); Bp = (const bf16*)(ws + WS_W2D);  N = DM;      K = DFF; }
            else if (ph == pg8::PH_PLE) { Ap = (const bf16*)(ws + WS_PB);  Bp = (const bf16*)(ws + WS_WP);   N = DM;      K = PLE; }
            else                        { Ap = (const bf16*)(ws + WS_XB);  Bp = (const bf16*)(ws + WS_WG);   N = DM;      K = DM; }
            pg8::Gemm g{Ap, Bp, MT, N, K}; pg8::StaticOrder S; S.init(MT, N, G, bx);
            pg8::EpiAny E{ws, A.out, A.in[0], A.in[1], dry ? 64 : ph};
            pg8::gemm_phase<pg8::EpiAny, pg8::StaticOrder, true, true>(lds, g, S, E);
        }
        if (pi + 1 < A.ph_hi * 2 && (dry || ph + 1 < A.ph_hi || ph == PROBE_PH)) { XcdBarrier b_; b_.bar = (unsigned*)(A.ws + WS_CTL) + CW_BAR; b_.x = xb_xcc_id(); b_.st = (volatile LAS unsigned*)(lds + MISC_OFF) + 8; xcd_barrier(b_); }
    }
}

extern "C" void kernel_launch(void* const* d_in, const int* in_sizes, int n_in, void* d_out, int out_size, void* d_ws, size_t ws_size, hipStream_t stream) {
    static int grid = 0;
    if (grid == 0) {
        if (n_in != 29 || out_size != (int)O_END || ws_size < WS_END) { fprintf(stderr, "kernel_launch: unexpected problem (n_in %d, out %d, ws %zu)\n", n_in, out_size, ws_size); grid = -1; return; }
        int dev = 0, cus = 0;
        if (hipGetDevice(&dev) != hipSuccess || hipDeviceGetAttribute(&cus, hipDeviceAttributeMultiprocessorCount, dev) != hipSuccess) { grid = -1; return; }
        if (hipFuncSetAttribute((const void*)mega, hipFuncAttributeMaxDynamicSharedMemorySize, LDS_BYTES) != hipSuccess) { fprintf(stderr, "kernel_launch: hipFuncSetAttribute failed\n"); grid = -1; return; }
        int per_cu = 0;
        if (hipOccupancyMaxActiveBlocksPerMultiprocessor(&per_cu, (const void*)mega, NTHR, LDS_BYTES) != hipSuccess || per_cu < 1) { fprintf(stderr, "kernel_launch: occupancy query says %d blocks per CU\n", per_cu); grid = -1; return; }
        (void)hipGetLastError();
        grid = cus;
    }
    if (grid < 0) return;
    Args a{};
    for (int i = 0; i < 29; ++i) a.in[i] = (const float*)d_in[i];
    a.out = (float*)d_out; a.ws = (unsigned char*)d_ws;
    if (hipMemsetAsync((char*)d_ws + WS_CTL, 0, CTL_ZERO_BYTES, stream) != hipSuccess) { fprintf(stderr, "kernel_launch: hipMemsetAsync failed\n"); return; }
#if MK_N_LAUNCHES == 1
    a.ph_lo = 0; a.ph_hi = N_PHASES;
    hipLaunchKernelGGL(mega, dim3(grid), dim3(NTHR), LDS_BYTES, stream, a);
#else
    for (int ph = 0; ph < N_PHASES; ++ph) {
        a.ph_lo = ph; a.ph_hi = ph + 1;
        hipLaunchKernelGGL(mega, dim3(grid), dim3(NTHR), LDS_BYTES, stream, a);
    }
#endif
}
```
